# Optimizing an MI355X kernel written in HIP

```python
import jax, jax.numpy as jnp
from jax import lax
import numpy as np

D_MODEL = 2048
BATCH = 4
SEQ = 2048
DEPTH = 4
DEC_BATCH = 2
DEC_SEQ = 8192
PAST_LEN = 128

FOURIER_WIDTH = D_MODEL // 4
FOURIER_GROUPS = 4
FOURIER_GROUP_DIM = FOURIER_WIDTH // FOURIER_GROUPS
HG_WIDTH = D_MODEL - FOURIER_WIDTH
HG_HEAD_DIM = 128
HG_HEADS = HG_WIDTH // HG_HEAD_DIM
IN_WIDTH = FOURIER_WIDTH + 5 * HG_WIDTH + 2 * D_MODEL
D_FF = 128 * ((8 * D_MODEL // 3 + 127) // 128)
CHUNK = 64
NORM_EPS = 1e-6
MIN_FORGET = 1e-30

kernel_name = "fnet_hgrn2_macaron_encoder"


def _rmsnorm(x, gain):
    xf = x.astype(jnp.float32)
    y = xf * lax.rsqrt(jnp.mean(xf * xf, axis=-1, keepdims=True) + NORM_EPS)
    return (y * gain.astype(jnp.float32)).astype(x.dtype)


def _swiglu_half(x, gain, w_in, w_down):
    u = _rmsnorm(x, gain)
    gate, up = jnp.split(u @ w_in, 2, axis=-1)
    return x + 0.5 * ((jax.nn.silu(gate) * up) @ w_down)


def _fourier_mix(u_f):
    b, s, _ = u_f.shape
    g = u_f.astype(jnp.float32).reshape(b, s, FOURIER_GROUPS, FOURIER_GROUP_DIM)
    y = jnp.fft.fft2(g, axes=(1, 3), norm="ortho").real
    return y.reshape(b, s, FOURIER_WIDTH).astype(u_f.dtype)


def _lower_bounds(lb_logits):
    p = jax.nn.softmax(lb_logits.astype(jnp.float32), axis=1)
    return jnp.maximum(jnp.cumsum(p, axis=1) - p[:, :1], 0.0)


def _forget(f_logit, lb):
    f = lb + (1.0 - lb) * jax.nn.sigmoid(f_logit)
    log_f = jnp.log(jnp.maximum(f, MIN_FORGET))
    k = (1.0 - lb) * jax.nn.sigmoid(-f_logit)
    return log_f, k


def _to_chunks(t):
    b, s, h, d = t.shape
    return t.reshape(b, s // CHUNK, CHUNK, h, d).transpose(1, 0, 3, 2, 4)


def _from_chunks(t):
    n, b, h, c, d = t.shape
    return t.transpose(1, 0, 3, 2, 4).reshape(b, n * c, h, d)


def _hgrn2_scan(q, k, v, log_f):
    qc, kc, vc = _to_chunks(q), _to_chunks(k), _to_chunks(v)
    bc = jnp.cumsum(_to_chunks(log_f), axis=-2)
    lower = jnp.tril(jnp.ones((CHUNK, CHUNK), dtype=bool))[:, :, None]

    def step(state, inp):
        q_c, k_c, v_c, b_c = inp
        rel = b_c[:, :, :, None, :] - b_c[:, :, None, :, :]
        decay = jnp.where(lower, jnp.exp(jnp.where(lower, rel, 0.0)), 0.0)
        scores = jnp.einsum("bhtk,bhsk,bhtsk->bhts", q_c, k_c, decay)
        o = (jnp.einsum("bhts,bhsv->bhtv", scores, v_c)
             + jnp.einsum("bhtk,bhkv->bhtv", q_c * jnp.exp(b_c), state))
        b_last = b_c[:, :, -1:, :]
        state = (jnp.exp(b_last)[:, :, 0, :, None] * state
                 + jnp.einsum("bhsk,bhsv->bhkv", k_c * jnp.exp(b_last - b_c), v_c))
        return state, o

    bsz, _, h, dk = q.shape
    init = jnp.zeros((bsz, h, dk, v.shape[-1]), jnp.float32)
    _, o = lax.scan(step, init, (qc, kc, vc, bc))
    return _from_chunks(o)


def _mixer(x, gain, w_in, lb_fwd, lb_bwd, hg_gain, w_fourier_out, w_hgrn_out, w_out):
    bsz, s, _ = x.shape
    u = _rmsnorm(x, gain)
    proj = u @ w_in
    idx = [FOURIER_WIDTH + j * HG_WIDTH for j in range(6)] + [FOURIER_WIDTH + 5 * HG_WIDTH + D_MODEL]
    u_f, q, z_fwd, z_bwd, i_in, g_out, gate_a, gate_b = jnp.split(proj, idx, axis=-1)

    branch_a = _fourier_mix(u_f) @ w_fourier_out

    def heads(t):
        return t.astype(jnp.float32).reshape(bsz, s, HG_HEADS, HG_HEAD_DIM)

    qh = jax.nn.silu(heads(q))
    vh = heads(i_in)
    logf_f, k_f = _forget(heads(z_fwd), lb_fwd.reshape(HG_HEADS, HG_HEAD_DIM))
    logf_b, k_b = _forget(heads(z_bwd), lb_bwd.reshape(HG_HEADS, HG_HEAD_DIM))
    o_fwd = _hgrn2_scan(qh, k_f, vh, logf_f)
    o_bwd = jnp.flip(_hgrn2_scan(jnp.flip(qh, 1), jnp.flip(k_b, 1), jnp.flip(vh, 1),
                                 jnp.flip(logf_b, 1)), 1)
    o = o_fwd + o_bwd
    o = o * lax.rsqrt(jnp.mean(o * o, axis=-1, keepdims=True) + NORM_EPS)
    o = o.reshape(bsz, s, HG_WIDTH) * hg_gain.astype(jnp.float32) * jax.nn.silu(g_out.astype(jnp.float32))
    branch_b = o.astype(x.dtype) @ w_hgrn_out

    merged = jax.nn.sigmoid(gate_a) * branch_a + jax.nn.sigmoid(gate_b) * branch_b
    return x + merged @ w_out


def _trunk(x, ffn1_norm, ffn1_w_in, ffn1_w_down, mix_norm, w_in, lb_logits, hg_norm,
           w_fourier_out, w_hgrn_out, w_out, ffn2_norm, ffn2_w_in, ffn2_w_down, final_norm):
    lb = _lower_bounds(lb_logits)
    for l in range(DEPTH):
        x = _swiglu_half(x, ffn1_norm[l], ffn1_w_in[l], ffn1_w_down[l])
        x = _mixer(x, mix_norm[l], w_in[l], lb[0, l], lb[1, l], hg_norm[l],
                   w_fourier_out[l], w_hgrn_out[l], w_out[l])
        x = _swiglu_half(x, ffn2_norm[l], ffn2_w_in[l], ffn2_w_down[l])
    return _rmsnorm(x, final_norm)


def setup_inputs(seed: int = 0) -> dict:
    key = jax.random.key(seed)
    ks = jax.random.split(key, 16)
    f32 = jnp.float32

    def w(k, shape, fan_in):
        return jax.random.normal(k, shape, f32) * (fan_in ** -0.5)

    def g(k, shape):
        return 1.0 + 0.02 * jax.random.normal(k, shape, f32)

    return {
        "x_prompt": jax.random.normal(ks[0], (BATCH, SEQ, D_MODEL), f32),
        "x_sample": jax.random.normal(ks[1], (DEC_BATCH, DEC_SEQ, D_MODEL), f32),
        "ffn1_norm": g(ks[2], (DEPTH, D_MODEL)),
        "ffn1_w_in": w(ks[3], (DEPTH, D_MODEL, 2 * D_FF), D_MODEL),
        "ffn1_w_down": w(ks[4], (DEPTH, D_FF, D_MODEL), D_FF),
        "mix_norm": g(ks[5], (DEPTH, D_MODEL)),
        "w_in": w(ks[6], (DEPTH, D_MODEL, IN_WIDTH), D_MODEL),
        "lb_logits": 0.5 * jax.random.normal(ks[7], (2, DEPTH, HG_WIDTH), f32),
        "hg_norm": g(ks[8], (DEPTH, HG_WIDTH)),
        "w_fourier_out": w(ks[9], (DEPTH, FOURIER_WIDTH, D_MODEL), FOURIER_WIDTH),
        "w_hgrn_out": w(ks[10], (DEPTH, HG_WIDTH, D_MODEL), HG_WIDTH),
        "w_out": w(ks[11], (DEPTH, D_MODEL, D_MODEL), D_MODEL),
        "ffn2_norm": g(ks[12], (DEPTH, D_MODEL)),
        "ffn2_w_in": w(ks[13], (DEPTH, D_MODEL, 2 * D_FF), D_MODEL),
        "ffn2_w_down": w(ks[14], (DEPTH, D_FF, D_MODEL), D_FF),
        "final_norm": g(ks[15], (D_MODEL,)),
    }


def reference(x_prompt, x_sample, ffn1_norm, ffn1_w_in, ffn1_w_down, mix_norm, w_in, lb_logits,
              hg_norm, w_fourier_out, w_hgrn_out, w_out, ffn2_norm, ffn2_w_in, ffn2_w_down,
              final_norm):
    y_prompt = _trunk(x_prompt, ffn1_norm, ffn1_w_in, ffn1_w_down, mix_norm, w_in, lb_logits,
                      hg_norm, w_fourier_out, w_hgrn_out, w_out, ffn2_norm, ffn2_w_in,
                      ffn2_w_down, final_norm)
    y_sample = _trunk(x_sample, ffn1_norm, ffn1_w_in, ffn1_w_down, mix_norm, w_in, lb_logits,
                      hg_norm, w_fourier_out, w_hgrn_out, w_out, ffn2_norm, ffn2_w_in,
                      ffn2_w_down, final_norm)
    return (y_prompt, y_sample)
```

```cpp
#include <hip/hip_runtime.h>
#include <cstdio>
#include <cstdint>

#define LAS __attribute__((address_space(3)))
#define GAS __attribute__((address_space(1)))
typedef unsigned short bf16;
typedef float f32x2 __attribute__((ext_vector_type(2)));
typedef unsigned u32x2 __attribute__((ext_vector_type(2)));
typedef unsigned short u16x4 __attribute__((ext_vector_type(4)));

namespace pg8 {
#define PG8_LAS __attribute__((address_space(3)))
typedef unsigned short bf16_t;
typedef short bf16x8 __attribute__((ext_vector_type(8)));
typedef float f32x4 __attribute__((ext_vector_type(4)));
typedef unsigned u32x4 __attribute__((ext_vector_type(4)));
constexpr int BM = 256, BK = 64, HALF = 128, HTB = HALF * BK * 2  , STAGE_BYTES = 8 * HTB, NXCD = 8, WGM = 8;

__host__ __device__ __forceinline__ int lds_byte(int r, int c) { const int st = (r >> 4) * 2 + (c >> 5), rr = r & 15, cc = c & 31, ob = rr * 64 + cc * 2; return st * 1024 + (ob ^ (((ob >> 9) & 1) << 5)); }
__host__ __device__ __forceinline__ void stage_rc(int b, int& R, int& C) { const int st = b / 1024, sb = b % 1024, swz = sb ^ (((sb >> 9) & 1) << 5); R = (st >> 1) * 16 + swz / 64; C = (st & 1) * 32 + (swz % 64) / 2; }
__host__ __device__ __forceinline__ int perm32(int rho) { const int n = rho >> 4, i = rho & 15; return 8 * (i >> 2) + 4 * n + (i & 3); }

struct Unit { int pm, pn, bz; };
struct Gemm { const bf16_t* A; const bf16_t* Bt; int M, N, K; };

struct StaticOrder {
    int nM, nN, nwg, G, c, rev;
    __host__ __device__ void init(int M, int N, int G_, int c_) { nM = M / BM; nN = N / BM; nwg = nM * nN; G = G_; c = c_; rev = 0; }
    __host__ __device__ bool next(int i, Unit& u) const {
        const long L = (long)i * G + c; if (L >= nwg) return false;
        int wgid = rev ? (nwg - 1 - (int)L) : (int)L; { const int q = nwg / NXCD, r = nwg % NXCD, xcd = wgid % NXCD, off = wgid / NXCD; wgid = (xcd < r ? xcd * (q + 1) : r * (q + 1) + (xcd - r) * q) + off; }
        const int nig = WGM * nN, gid = wgid / nig, fm = gid * WGM, gsz = (nM - fm) < WGM ? (nM - fm) : WGM;
        u.pm = fm + ((wgid % nig) % gsz); u.pn = (wgid % nig) / gsz; u.bz = 0; return true;
    }
    __device__ __forceinline__ const char* abase(const Gemm& g, const Unit& u) const { return (const char*)g.A + (size_t)u.pm * (size_t)(2 * BM) * g.K; }
    __device__ __forceinline__ const char* bbase(const Gemm& g, const Unit& u) const { return (const char*)g.Bt + (size_t)u.pn * (size_t)(2 * BM) * g.K; }
    __device__ __forceinline__ void a_ready(const Unit&) const {}
    __device__ __forceinline__ void done(const Unit&) const {}
};


template <class Epi, class Sched, bool ALIGN_EPI = false, bool SP2 = false>
__device__ __forceinline__ void gemm_phase(PG8_LAS unsigned char* lds, const Gemm g, const Sched& S, const Epi& E, int tid_in) {
    int tid_ = tid_in; asm volatile("" : "+v"(tid_));
    const int tid = tid_, wid = __builtin_amdgcn_readfirstlane(tid >> 6), lane = tid & 63, wr = wid >> 2, wc = wid & 3, fr = lane & 15, fq = lane >> 4;
    const int K = g.K, nt = K / BK;
    unsigned voffA[2], voffB[2];
#pragma unroll
    for (int i = 0; i < 2; ++i) { int R, C; stage_rc(tid * 16 + i * 8192, R, C); const int Rb = Epi::PERM ? ((R & ~31) + perm32(R & 31)) : R;
        voffA[i] = (unsigned)(R * K + C) * 2u; voffB[i] = (unsigned)(Rb * K + C) * 2u; }
    const size_t kstep = (size_t)(BK * 2);
    const size_t hstep = (size_t)HALF * K * 2;
    const unsigned ldsw = (unsigned)wid * 1024u;
    const int aoff = lds_byte(wr * 64 + fr, fq * 8), boff = lds_byte(wc * 32 + fr, fq * 8);
#define PG8_SA(b, h) (((b) * 2 + (h)) * HTB)
#define PG8_SB(b, h) ((4 + (b) * 2 + (h)) * HTB)
#define PG8_STAGE(bufoff, gbase, voff) do { _Pragma("unroll") for (int _i = 0; _i < 2; ++_i) \
        __builtin_amdgcn_global_load_lds((const unsigned*)((const char*)(gbase) + (voff)[_i]), (PG8_LAS unsigned*)(lds + (bufoff) + ldsw + _i * 8192), 16, 0, 0); } while (0)
#define PG8_LDA(dst, b, h) do { _Pragma("unroll") for (int m = 0; m < 4; ++m) _Pragma("unroll") for (int k = 0; k < 2; ++k) dst[m][k] = *(const PG8_LAS bf16x8*)(lds + PG8_SA(b, h) + aoff + m * 2048 + k * 1024); } while (0)
#define PG8_LDB(dst, b, h) do { _Pragma("unroll") for (int n = 0; n < 2; ++n) _Pragma("unroll") for (int k = 0; k < 2; ++k) dst[n][k] = *(const PG8_LAS bf16x8*)(lds + PG8_SB(b, h) + boff + n * 2048 + k * 1024); } while (0)
#define PG8_MMA(ai, bj, At, Bt) do { __builtin_amdgcn_s_setprio(1); _Pragma("unroll") for (int m = 0; m < 4; ++m) _Pragma("unroll") for (int n = 0; n < 2; ++n) _Pragma("unroll") for (int k = 0; k < 2; ++k) \
        acc[ai][bj][m][n] = __builtin_amdgcn_mfma_f32_16x16x32_bf16(Bt[n][k], At[m][k], acc[ai][bj][m][n], 0, 0, 0); __builtin_amdgcn_s_setprio(0); } while (0)
#define PG8_WAIT_V(n) asm volatile("s_waitcnt vmcnt(" #n ")" ::: "memory")
#define PG8_WAIT_L(n) asm volatile("s_waitcnt lgkmcnt(" #n ")" ::: "memory")
#define PG8_BAR __builtin_amdgcn_s_barrier()
#define PG8_SCHED __builtin_amdgcn_sched_barrier(0)
    Unit cur, nxt; int ui = 0;
    if (!S.next(0, cur)) return;
    f32x4 acc[2][2][4][2];
#pragma unroll
    for (int a = 0; a < 2; ++a)
#pragma unroll
        for (int b = 0; b < 2; ++b)
#pragma unroll
            for (int m = 0; m < 4; ++m)
#pragma unroll
                for (int n = 0; n < 2; ++n) acc[a][b][m][n] = (f32x4){0.f, 0.f, 0.f, 0.f};
    bf16x8 At[4][2], B0[2][2], B1[2][2];
    const char* cA = S.abase(g, cur); const char* cB = S.bbase(g, cur);
    S.a_ready(cur);
    if constexpr (SP2) {
        PG8_STAGE(PG8_SB(0, 0), cB, voffB); PG8_STAGE(PG8_SB(0, 1), cB + hstep, voffB); PG8_STAGE(PG8_SA(0, 0), cA, voffA); PG8_STAGE(PG8_SA(0, 1), cA + hstep, voffA);
        if (wr == 1) PG8_BAR;
        PG8_WAIT_V(2); PG8_BAR;
        PG8_STAGE(PG8_SB(1, 0), cB + kstep, voffB); PG8_STAGE(PG8_SA(1, 0), cA + kstep, voffA); PG8_STAGE(PG8_SB(1, 1), cB + hstep + kstep, voffB);
        PG8_WAIT_V(6); PG8_BAR;
    } else {
        PG8_STAGE(PG8_SB(0, 0), cB, voffB); PG8_STAGE(PG8_SA(0, 0), cA, voffA); PG8_STAGE(PG8_SB(0, 1), cB + hstep, voffB); PG8_STAGE(PG8_SA(0, 1), cA + hstep, voffA);
        if (wr == 1) PG8_BAR;
        PG8_WAIT_V(4); PG8_BAR;
        PG8_STAGE(PG8_SB(1, 0), cB + kstep, voffB); PG8_STAGE(PG8_SA(1, 0), cA + kstep, voffA); PG8_STAGE(PG8_SB(1, 1), cB + hstep + kstep, voffB);
        PG8_WAIT_V(6); PG8_BAR;
    }
    for (;;) {
        const bool has_next = S.next(ui + 1, nxt);
        const char* nA = has_next ? S.abase(g, nxt) : cA; const char* nB = has_next ? S.bbase(g, nxt) : cB;
        for (int t = 0; t < nt; t += 2) {
            const bool last = (t == nt - 2);
            const char* a1 = cA + (size_t)(t + 1) * kstep;
            const char* a2 = last ? nA : cA + (size_t)(t + 2) * kstep; const char* b2 = last ? nB : cB + (size_t)(t + 2) * kstep;
            const char* a3 = a2 + kstep; const char* b3 = b2 + kstep;
            if (last && has_next) S.a_ready(nxt);
            if constexpr (SP2) {
            PG8_LDB(B0, 0, 0); PG8_LDB(B1, 0, 1); PG8_SCHED; PG8_LDA(At, 0, 0); PG8_STAGE(PG8_SA(1, 1), a1 + hstep, voffA);
            PG8_WAIT_V(8); PG8_WAIT_L(0); PG8_BAR; PG8_MMA(0, 0, At, B0); PG8_MMA(0, 1, At, B1); PG8_BAR; PG8_SCHED;
            PG8_LDA(At, 0, 1); PG8_STAGE(PG8_SB(0, 0), b2, voffB); PG8_STAGE(PG8_SB(0, 1), b2 + hstep, voffB); PG8_STAGE(PG8_SA(0, 0), a2, voffA);
            PG8_WAIT_V(8); PG8_WAIT_L(0); PG8_BAR; PG8_MMA(1, 0, At, B0); PG8_MMA(1, 1, At, B1); PG8_BAR; PG8_SCHED;
            PG8_LDB(B0, 1, 0); PG8_LDB(B1, 1, 1); PG8_SCHED; PG8_LDA(At, 1, 0); PG8_STAGE(PG8_SA(0, 1), a2 + hstep, voffA);
            PG8_WAIT_V(8); PG8_WAIT_L(0); PG8_BAR; PG8_MMA(0, 0, At, B0); PG8_MMA(0, 1, At, B1); PG8_BAR; PG8_SCHED;
            PG8_LDA(At, 1, 1); PG8_STAGE(PG8_SB(1, 0), b3, voffB); PG8_STAGE(PG8_SB(1, 1), b3 + hstep, voffB); PG8_STAGE(PG8_SA(1, 0), a3, voffA);
            PG8_WAIT_V(8); PG8_WAIT_L(0); PG8_BAR; PG8_MMA(1, 0, At, B0); PG8_MMA(1, 1, At, B1); PG8_BAR; PG8_SCHED;
            } else {
            PG8_LDB(B0, 0, 0); PG8_SCHED; PG8_LDA(At, 0, 0); PG8_STAGE(PG8_SA(1, 1), a1 + hstep, voffA);
            PG8_WAIT_L(8); PG8_BAR; PG8_WAIT_L(0); PG8_MMA(0, 0, At, B0); PG8_BAR; PG8_SCHED;
            PG8_LDB(B1, 0, 1); PG8_STAGE(PG8_SB(0, 0), b2, voffB);
            PG8_BAR; PG8_WAIT_L(0); PG8_MMA(0, 1, At, B1); PG8_BAR;
            PG8_LDA(At, 0, 1); PG8_STAGE(PG8_SA(0, 0), a2, voffA);
            PG8_BAR; PG8_WAIT_L(0); PG8_MMA(1, 0, At, B0); PG8_BAR; PG8_SCHED;
            PG8_STAGE(PG8_SB(0, 1), b2 + hstep, voffB);
            PG8_WAIT_V(6); PG8_BAR; PG8_MMA(1, 1, At, B1); PG8_BAR;
            PG8_LDB(B0, 1, 0); PG8_SCHED; PG8_LDA(At, 1, 0); PG8_STAGE(PG8_SA(0, 1), a2 + hstep, voffA);
            PG8_WAIT_L(8); PG8_BAR; PG8_WAIT_L(0); PG8_MMA(0, 0, At, B0); PG8_BAR; PG8_SCHED;
            PG8_LDB(B1, 1, 1); PG8_STAGE(PG8_SB(1, 0), b3, voffB);
            PG8_BAR; PG8_WAIT_L(0); PG8_MMA(0, 1, At, B1); PG8_BAR;
            PG8_LDA(At, 1, 1); PG8_STAGE(PG8_SA(1, 0), a3, voffA);
            PG8_BAR; PG8_WAIT_L(0); PG8_MMA(1, 0, At, B0); PG8_BAR; PG8_SCHED;
            PG8_STAGE(PG8_SB(1, 1), b3 + hstep, voffB);
            PG8_WAIT_V(6); PG8_BAR; PG8_MMA(1, 1, At, B1); PG8_BAR;
            }
        }
        if constexpr (ALIGN_EPI) { if (wr == 0) PG8_BAR; }
        if constexpr (Epi::SCALE != 0) E.prescale(acc, cur, wr, wc, fr, fq, lds, tid);
        if constexpr (!Epi::AFTER_DRAIN) { E(acc, cur, wr, wc, fr, fq); S.done(cur); }
        if (!has_next) break;
#pragma unroll
        for (int a = 0; a < 2; ++a)
#pragma unroll
            for (int b = 0; b < 2; ++b)
#pragma unroll
                for (int m = 0; m < 4; ++m)
#pragma unroll
                    for (int n = 0; n < 2; ++n) acc[a][b][m][n] = (f32x4){0.f, 0.f, 0.f, 0.f};
        cur = nxt; cA = nA; cB = nB; ++ui;
        if constexpr (ALIGN_EPI) { if (wr == 1) PG8_BAR; }
    }
    PG8_WAIT_V(0);
    if constexpr (!ALIGN_EPI) { if (wr == 0) PG8_BAR; }
    PG8_BAR;
    if constexpr (Epi::AFTER_DRAIN) { E.fused(acc, cur, wr, wc, fr, fq, lds, wid, lane); S.done(cur); }
#undef PG8_SA
#undef PG8_SB
#undef PG8_STAGE
#undef PG8_LDA
#undef PG8_LDB
#undef PG8_MMA
#undef PG8_WAIT_V
#undef PG8_WAIT_L
#undef PG8_BAR
#undef PG8_SCHED
}

template <class Epi, class Sched>
__device__ __forceinline__ void gemm_phase_simple(const Gemm g, const Sched& S, const Epi& E, int tid_in) {
    int tid_ = tid_in; asm volatile("" : "+v"(tid_));
    const int tid = tid_, wid = __builtin_amdgcn_readfirstlane(tid >> 6), lane = tid & 63, wr = wid >> 2, wc = wid & 3, fr = lane & 15, fq = lane >> 4;
    const int K = g.K;
    Unit cur;
    for (int ui = 0; S.next(ui, cur); ++ui) {
        f32x4 acc[2][2][4][2];
#pragma unroll
        for (int a = 0; a < 2; ++a)
#pragma unroll
            for (int b = 0; b < 2; ++b)
#pragma unroll
                for (int m = 0; m < 4; ++m)
#pragma unroll
                    for (int n = 0; n < 2; ++n) acc[a][b][m][n] = (f32x4){0.f, 0.f, 0.f, 0.f};
        const bf16_t* A0 = (const bf16_t*)S.abase(g, cur); const bf16_t* B0 = (const bf16_t*)S.bbase(g, cur);
        for (int k0 = 0; k0 < K; k0 += 32) {
            bf16x8 Af[2][4], Bf[2][2];
#pragma unroll
            for (int ai = 0; ai < 2; ++ai)
#pragma unroll
                for (int m = 0; m < 4; ++m) Af[ai][m] = *(const bf16x8*)(A0 + (size_t)(ai * 128 + wr * 64 + m * 16 + fr) * K + k0 + 8 * fq);
#pragma unroll
            for (int bj = 0; bj < 2; ++bj)
#pragma unroll
                for (int n = 0; n < 2; ++n) { const int rho = 16 * n + fr, rb = Epi::PERM ? perm32(rho) : rho;
                    Bf[bj][n] = *(const bf16x8*)(B0 + (size_t)(bj * 128 + wc * 32 + rb) * K + k0 + 8 * fq); }
#pragma unroll
            for (int ai = 0; ai < 2; ++ai)
#pragma unroll
                for (int bj = 0; bj < 2; ++bj)
#pragma unroll
                    for (int m = 0; m < 4; ++m)
#pragma unroll
                        for (int n = 0; n < 2; ++n) acc[ai][bj][m][n] = __builtin_amdgcn_mfma_f32_16x16x32_bf16(Bf[bj][n], Af[ai][m], acc[ai][bj][m][n], 0, 0, 0);
        }
        E(acc, cur, wr, wc, fr, fq);
    }
}
}

#define XB_TMO      128
#define XB_XCNT(j)  (256  + 64 * (j))
#define XB_XSUB(j)  (1280 + 64 * (j))
#define XB_XGEN(j)  (2304 + 64 * (j))
#define XB_TOP      3328
#define XB_TOPGEN   3392
#define XCD_BAR_WORDS 3456
#define XB_SPIN_CAP (1u << 22)

__device__ __forceinline__ unsigned xb_ld(unsigned* p)              { return __hip_atomic_load(p, __ATOMIC_RELAXED, __HIP_MEMORY_SCOPE_AGENT); }
__device__ __forceinline__ unsigned xb_add(unsigned* p, unsigned v) { return __hip_atomic_fetch_add(p, v, __ATOMIC_RELAXED, __HIP_MEMORY_SCOPE_AGENT); }
__device__ __forceinline__ unsigned xb_xcc_id() { return (unsigned)__builtin_amdgcn_s_getreg((3 << 11) | 20) & 0xFu; }
#define XB_SPIN(cond, bar) do { unsigned _sp = 0; while (cond) { __builtin_amdgcn_s_sleep(1); \
    if ((++_sp & 255u) == 0u) { if (xb_ld(&(bar)[XB_TMO])) break; if (_sp > XB_SPIN_CAP) { atomicAdd(&(bar)[XB_TMO], 1u); break; } } } } while (0)

struct XcdBarrier {
    unsigned* bar; unsigned x;
    volatile LAS unsigned* st;
};

__device__ __forceinline__ XcdBarrier xcd_barrier_post(unsigned* bar, volatile LAS unsigned* st) {
    XcdBarrier b; b.bar = bar; b.x = xb_xcc_id(); b.st = st;
    if (threadIdx.x == 0) (void)xb_add(&bar[XB_XCNT(b.x)], 1u);
    return b;
}
__device__ __forceinline__ void xcd_barrier_complete(unsigned* bar, unsigned x, unsigned& nloc, unsigned& nx) {
    const unsigned G = gridDim.x * gridDim.y * gridDim.z;
    unsigned sum, cnt, mine, sp = 0u;
    for (;;) {
        sum = 0u; cnt = 0u; mine = 0u;
#pragma unroll
        for (unsigned j = 0; j < 16; ++j) { const unsigned c = xb_ld(&bar[XB_XCNT(j)]); sum += c; cnt += (c > 0u) ? 1u : 0u; mine = (j == x) ? c : mine; }
        if (sum == G) break;
        __builtin_amdgcn_s_sleep(1);
        if ((++sp & 255u) == 0u) { if (xb_ld(&bar[XB_TMO])) break; if (sp > XB_SPIN_CAP) { atomicAdd(&bar[XB_TMO], 1u); break; } }
    }
    nloc = mine > 0u ? mine : 1u; nx = cnt > 0u ? cnt : 1u;
}

__device__ __forceinline__ void xcd_barrier(const XcdBarrier& b) {
    asm volatile("s_waitcnt vmcnt(0)" ::: "memory");
    __syncthreads();
    if (threadIdx.x == 0) {
        unsigned* bar = b.bar;
        __builtin_amdgcn_s_waitcnt(0);
        unsigned nloc = b.st[0], nx = b.st[1];
        if (nloc == 0u) { xcd_barrier_complete(bar, b.x, nloc, nx); b.st[0] = nloc; b.st[1] = nx; }
        const unsigned old = xb_add(&bar[XB_XSUB(b.x)], 1u);
        const unsigned gen = old / nloc;
        if (old + 1u == (gen + 1u) * nloc) {
            __builtin_amdgcn_fence(__ATOMIC_RELEASE, "agent");
            asm volatile("s_waitcnt vmcnt(0)" ::: "memory");
            const unsigned og = xb_add(&bar[XB_TOP], 1u);
            const unsigned tg = og / nx;
            if (og + 1u == (tg + 1u) * nx) xb_add(&bar[XB_TOPGEN], 1u);
            else XB_SPIN(xb_ld(&bar[XB_TOPGEN]) == tg, bar);
            __builtin_amdgcn_fence(__ATOMIC_ACQUIRE, "agent");
            xb_add(&bar[XB_XGEN(b.x)], 1u);
            asm volatile("s_waitcnt vmcnt(0)" ::: "memory");
        } else {
            XB_SPIN(xb_ld(&bar[XB_XGEN(b.x)]) == gen, bar);
            __builtin_amdgcn_fence(__ATOMIC_ACQUIRE, "agent");
            asm volatile("s_waitcnt vmcnt(0)" ::: "memory");
        }
    }
    __syncthreads();
}


using pg8::f32x4; using pg8::u32x4; using pg8::bf16x8;

constexpr int T = 24576, D = 2048, FF = 5504, HG = 1536, FW = 512, NIN = 12288, DEPTH = 4, TP = 8192;
constexpr float EPS = 1e-6f;
#define STAGE_TOL 0.012f
#define CHK_LAYER 1
#define CHK_SKIP 99
#define SCAN_FN phase_scan_fast
#define GEMM_ALIGN true
#define GEMM_SP2 true
#define GEMM_SIMPLE 0
#if GEMM_SIMPLE == 2
#define GEMM_CALL(EPI, SCH) if (run == 0) { pg8::gemm_phase<EPI, SCH, GEMM_ALIGN, GEMM_SP2>(C.lds, g, S, E, C.tid); } else { pg8::gemm_phase_simple<EPI, SCH>(g, S, E, C.tid); }
#elif GEMM_SIMPLE == 1
#define GEMM_CALL(EPI, SCH) pg8::gemm_phase_simple<EPI, SCH>(g, S, E, C.tid);
#else
#define GEMM_CALL(EPI, SCH) pg8::gemm_phase<EPI, SCH, GEMM_ALIGN, GEMM_SP2>(C.lds, g, S, E, C.tid);
#endif
#ifndef MK_MULTI
#define MK_MULTI 0
#endif
#ifdef STAGE_CHECK
constexpr int NPH_LAYER = 24;
#else
constexpr int NPH_LAYER = 10;
#endif
#ifdef CSUM_CHECK
constexpr int NPH = 2 * 2 * (1 + NPH_LAYER * DEPTH + 1) + 1 + 2 * 2 * DEPTH;
#else
#ifdef CMP_G3
constexpr int NPH = 1 + (NPH_LAYER + 1) * DEPTH + 1;
#else
constexpr int NPH = 2 + NPH_LAYER * DEPTH + 1;
#endif
#endif

constexpr size_t WS_CTL = 0, CTL_BYTES = 1u << 20;
constexpr size_t WS_LB = WS_CTL + CTL_BYTES;
constexpr size_t SZ_WI = (size_t)2 * FF * D * 2, SZ_WD = (size_t)D * FF * 2;
constexpr size_t WS_W1I = WS_LB + 65536;
constexpr size_t WS_W1D = WS_W1I + SZ_WI;
constexpr size_t WS_WIN = WS_W1D + SZ_WD;
constexpr size_t WS_WFO = WS_WIN + (size_t)NIN * D * 2;
constexpr size_t WS_WHO = WS_WFO + (size_t)D * FW * 2;
constexpr size_t WS_WOU = WS_WHO + (size_t)D * HG * 2;
constexpr size_t WS_W2I = WS_WOU + (size_t)D * D * 2;
constexpr size_t WS_W2D = WS_W2I + SZ_WI;
constexpr size_t WS_DM8 = WS_W2D + SZ_WD;
constexpr size_t WS_X16 = WS_DM8 + (size_t)2 * 4096 * 8192 * 2;
static_assert(WS_X16 + (size_t)24576 * 2048 * 2 <= WS_DM8 + (size_t)8192 * 16384 * 2, "X16 fits behind the DFT matrices");
constexpr size_t WS_DM2 = WS_DM8 + (size_t)8192 * 16384 * 2;
constexpr size_t WS_U = WS_DM2 + (size_t)2048 * 4096 * 2;
constexpr size_t WS_BIG = WS_U + (size_t)T * D * 2;
constexpr size_t WS_H = WS_BIG;
constexpr size_t WS_PQT = WS_BIG;
constexpr size_t WS_QS = WS_PQT + (size_t)T * 1024 * 2;
constexpr size_t WS_VV = WS_QS + (size_t)T * HG * 2;
constexpr size_t WS_GO = WS_VV + (size_t)T * HG * 2;
constexpr size_t WS_SA = WS_GO + (size_t)T * HG * 2;
constexpr size_t WS_SB = WS_SA + (size_t)T * D * 2;
constexpr size_t WS_LF = WS_SB + (size_t)T * D * 2;
constexpr size_t WS_PP = WS_LF;
constexpr size_t WS_MG = WS_PP + (size_t)T * D * 4;
constexpr size_t WS_BIG_END = WS_LF + (size_t)2 * T * HG * 4;
static_assert(WS_MG + (size_t)T * D * 2 <= WS_BIG_END, "alias map");
static_assert(WS_H + (size_t)T * FF * 2 <= WS_BIG_END, "alias map");
constexpr size_t WS_OF = WS_BIG_END;
constexpr size_t WS_OO = WS_OF + (size_t)T * HG * 4;
constexpr size_t WS_YY = WS_OO + (size_t)T * HG * 2;
constexpr size_t WS_OB = WS_YY + (size_t)T * FW * 2;
constexpr size_t WS_EB = WS_OB + (size_t)T * HG * 4;
constexpr size_t WS_LS = WS_EB + (size_t)144 * 16384 * 4;
constexpr size_t WS_RS = WS_LS + (size_t)144 * 128 * 4;
constexpr size_t WS_END = WS_RS + (size_t)24576 * 32 * 4;
constexpr int CW_BAR = 4096;
constexpr int LDS_BYTES = 147456, LDS_BAR_OFF = 131072;

struct Args { const float* in[16]; float* out; unsigned char* ws; int ph_lo, ph_hi; };
__device__ __forceinline__ float bf2f(unsigned short h) { return __uint_as_float(((unsigned)h) << 16); }
__device__ __forceinline__ unsigned pk2(float lo, float hi) { unsigned r; asm volatile("v_cvt_pk_bf16_f32 %0, %1, %2" : "=v"(r) : "v"(lo), "v"(hi)); return r; }
__device__ __forceinline__ float sigm(float x) { return __builtin_amdgcn_rcpf(1.0f + __expf(-x)); }
__device__ __forceinline__ float siluf(float x) { return x * sigm(x); }
__device__ __forceinline__ float wave_sum(float v, int lane) {
#pragma unroll
    for (int o = 1; o < 64; o <<= 1) v += __builtin_bit_cast(float, __builtin_amdgcn_ds_bpermute((lane ^ o) << 2, __builtin_bit_cast(int, v)));
    return v;
}
__device__ __forceinline__ const LAS float* rstd_panel(const float* RS, int panel_, LAS unsigned char* lds, int tid_) {
    int tid = tid_, panel = panel_; asm volatile("" : "+s"(panel));
    LAS float* rc = (LAS float*)(lds + LDS_BAR_OFF + 1024); volatile LAS int* tag = (volatile LAS int*)(lds + LDS_BAR_OFF + 64);
    asm volatile("" : "+v"(tid));
    if (*tag != panel) {
        __syncthreads();
        const f32x4* p4 = (const f32x4*)(RS + ((size_t)panel * 256 + (tid >> 1)) * 32 + (tid & 1) * 16);
        const f32x4 a0 = p4[0], a1 = p4[1], a2 = p4[2], a3 = p4[3];
        float sm = ((a0.x + a0.y) + (a0.z + a0.w)) + ((a1.x + a1.y) + (a1.z + a1.w)) + ((a2.x + a2.y) + (a2.z + a2.w)) + ((a3.x + a3.y) + (a3.z + a3.w));
        sm += __builtin_bit_cast(float, __builtin_amdgcn_ds_bpermute(((tid & 63) ^ 1) << 2, __builtin_bit_cast(int, sm)));
        if ((tid & 1) == 0) rc[tid >> 1] = 1.0f / sqrtf(sm * (1.0f / D) + EPS);
        if (tid == 0) *tag = panel;
        __syncthreads();
    }
    return rc;
}
#define LDS_WAIT() asm volatile("s_waitcnt lgkmcnt(0)" ::: "memory")

struct BatchOrder {
    int nM, nN, nb, G, c; size_t bstride;
    __device__ __forceinline__ bool next(int i, pg8::Unit& u) const {
        const long L = (long)i * G + c; const int per = nM * nN; if (L >= (long)nb * per) return false;
        u.bz = (int)(L / per); const int r = (int)(L % per); u.pm = r / nN; u.pn = r % nN; return true;
    }
    __device__ __forceinline__ const char* abase(const pg8::Gemm& g, const pg8::Unit& u) const { return (const char*)g.A + (size_t)u.pm * (size_t)512 * g.K; }
    __device__ __forceinline__ const char* bbase(const pg8::Gemm& g, const pg8::Unit& u) const { return (const char*)g.Bt + (size_t)u.bz * bstride + (size_t)u.pn * (size_t)512 * g.K; }
    __device__ __forceinline__ void a_ready(const pg8::Unit&) const {}
    __device__ __forceinline__ void done(const pg8::Unit&) const {}
};

#define ACC_T const f32x4 (&acc)[2][2][4][2]

__device__ __forceinline__ void row_prescale(f32x4 (&acc)[2][2][4][2], const float* RS, int panel, int wr, int fr, LAS unsigned char* lds, int tid) {
    const LAS float* rc = rstd_panel(RS, panel, lds, tid);
    int frl = fr; asm volatile("" : "+v"(frl));
#pragma unroll
    for (int ai = 0; ai < 2; ++ai)
#pragma unroll
        for (int m = 0; m < 4; ++m) { const float r = rc[ai * 128 + wr * 64 + m * 16 + frl];
#pragma unroll
            for (int bj = 0; bj < 2; ++bj) { acc[ai][bj][m][0] *= r; acc[ai][bj][m][1] *= r; } }
}
__device__ __forceinline__ void col_prescale(f32x4 (&acc)[2][2][4][2], const float* RS, int panel, int wc, int fq, LAS unsigned char* lds, int tid) {
    const LAS float* rc = rstd_panel(RS, panel, lds, tid);
    int fql = fq; asm volatile("" : "+v"(fql));
#pragma unroll
    for (int bj = 0; bj < 2; ++bj)
#pragma unroll
        for (int n = 0; n < 2; ++n) { const f32x4 r = *(const LAS f32x4*)(rc + bj * 128 + wc * 32 + 8 * fql + 4 * n);
#pragma unroll
            for (int ai = 0; ai < 2; ++ai)
#pragma unroll
                for (int m = 0; m < 4; ++m) acc[ai][bj][m][n] *= r; }
}
struct EpiSwiglu {
    static constexpr bool PERM = true, AFTER_DRAIN = false; static constexpr int SCALE = 1;
    unsigned char* ws;
    __device__ __forceinline__ void prescale(f32x4 (&acc)[2][2][4][2], const pg8::Unit& u, int wr, int wc, int fr, int fq, LAS unsigned char* lds, int tid) const { row_prescale(acc, (const float*)(ws + WS_RS), u.pm, wr, fr, lds, tid); }
    __device__ __forceinline__ void operator()(ACC_T, const pg8::Unit& u, int wr, int wc, int fr, int fq) const {
        bf16* H = (bf16*)(ws + WS_H);
        const int row0 = u.pm * 256 + wr * 64 + fr, col0 = u.pn * 128 + wc * 32 + 8 * fq;
#pragma unroll
        for (int ai = 0; ai < 2; ++ai)
#pragma unroll
            for (int m = 0; m < 4; ++m) {
                bf16* rowp = H + (size_t)(row0 + ai * 128 + m * 16) * FF + col0;
                const f32x4 g0 = acc[ai][0][m][0], g1 = acc[ai][0][m][1], u0 = acc[ai][1][m][0], u1 = acc[ai][1][m][1];
                u32x4 w;
                w.x = pk2(siluf(g0[0]) * u0[0], siluf(g0[1]) * u0[1]); w.y = pk2(siluf(g0[2]) * u0[2], siluf(g0[3]) * u0[3]);
                w.z = pk2(siluf(g1[0]) * u1[0], siluf(g1[1]) * u1[1]); w.w = pk2(siluf(g1[2]) * u1[2], siluf(g1[3]) * u1[3]);
                *(u32x4*)rowp = w;
            }
    }
};

struct EpiResid {
    static constexpr bool PERM = true, AFTER_DRAIN = false; static constexpr int SCALE = 0;
    const float* xp; const float* xs; bf16* x16; float scale; float* rs;
    __device__ __forceinline__ void operator()(ACC_T, const pg8::Unit& u, int wr, int wc, int fr, int fq) const {
        const int row0 = u.pm * 256 + wr * 64 + fr, col0 = u.pn * 256 + wc * 32 + 8 * fq;
        float sq[2][4];
#pragma unroll
        for (int ai = 0; ai < 2; ++ai)
#pragma unroll
            for (int m = 0; m < 4; ++m) sq[ai][m] = 0.f;
        if (xp != nullptr) {
#pragma unroll
            for (int ai = 0; ai < 2; ++ai)
#pragma unroll
                for (int mp = 0; mp < 2; ++mp) {
                    f32x4 xv[2][2][2];
#pragma unroll
                    for (int mm = 0; mm < 2; ++mm) { const int row = row0 + ai * 128 + (2 * mp + mm) * 16;
                        const float* src = (row < TP ? xp + (size_t)row * D : xs + (size_t)(row - TP) * D) + col0;
#pragma unroll
                        for (int bj = 0; bj < 2; ++bj)
#pragma unroll
                            for (int n = 0; n < 2; ++n) xv[mm][bj][n] = *(const f32x4*)(src + bj * 128 + 4 * n); }
#pragma unroll
                    for (int mm = 0; mm < 2; ++mm) { const int m = 2 * mp + mm, row = row0 + ai * 128 + m * 16; bf16* dst = x16 + (size_t)row * D + col0;
#pragma unroll
                        for (int bj = 0; bj < 2; ++bj) { const f32x4 v0 = xv[mm][bj][0] + acc[ai][bj][m][0] * scale, v1 = xv[mm][bj][1] + acc[ai][bj][m][1] * scale;
                            sq[ai][m] += ((v0[0] * v0[0] + v0[1] * v0[1]) + (v0[2] * v0[2] + v0[3] * v0[3])) + ((v1[0] * v1[0] + v1[1] * v1[1]) + (v1[2] * v1[2] + v1[3] * v1[3]));
                            u32x4 w; w.x = pk2(v0[0], v0[1]); w.y = pk2(v0[2], v0[3]); w.z = pk2(v1[0], v1[1]); w.w = pk2(v1[2], v1[3]); *(u32x4*)(dst + bj * 128) = w; __builtin_amdgcn_sched_barrier(0); } }
                }
        } else {
#pragma unroll
            for (int ai = 0; ai < 2; ++ai) {
                u32x4 xv[4][2];
#pragma unroll
                for (int m = 0; m < 4; ++m)
#pragma unroll
                    for (int bj = 0; bj < 2; ++bj) xv[m][bj] = *(const u32x4*)(x16 + (size_t)(row0 + ai * 128 + m * 16) * D + col0 + bj * 128);
#pragma unroll
                for (int m = 0; m < 4; ++m)
#pragma unroll
                    for (int bj = 0; bj < 2; ++bj) { const u32x4 pv = xv[m][bj];
                        const f32x4 q0 = {__uint_as_float(pv.x << 16), __uint_as_float(pv.x & 0xffff0000u), __uint_as_float(pv.y << 16), __uint_as_float(pv.y & 0xffff0000u)};
                        const f32x4 q1 = {__uint_as_float(pv.z << 16), __uint_as_float(pv.z & 0xffff0000u), __uint_as_float(pv.w << 16), __uint_as_float(pv.w & 0xffff0000u)};
                        const f32x4 v0 = q0 + acc[ai][bj][m][0] * scale, v1 = q1 + acc[ai][bj][m][1] * scale;
                        sq[ai][m] += ((v0[0] * v0[0] + v0[1] * v0[1]) + (v0[2] * v0[2] + v0[3] * v0[3])) + ((v1[0] * v1[0] + v1[1] * v1[1]) + (v1[2] * v1[2] + v1[3] * v1[3]));
                        u32x4 w; w.x = pk2(v0[0], v0[1]); w.y = pk2(v0[2], v0[3]); w.z = pk2(v1[0], v1[1]); w.w = pk2(v1[2], v1[3]);
                        *(u32x4*)(x16 + (size_t)(row0 + ai * 128 + m * 16) * D + col0 + bj * 128) = w; }
            }
        }
        const int ln = fq * 16 + fr;
#pragma unroll
        for (int ai = 0; ai < 2; ++ai)
#pragma unroll
            for (int m = 0; m < 4; ++m) { float v = sq[ai][m];
                v += __builtin_bit_cast(float, __builtin_amdgcn_ds_bpermute((ln ^ 16) << 2, __builtin_bit_cast(int, v)));
                v += __builtin_bit_cast(float, __builtin_amdgcn_ds_bpermute((ln ^ 32) << 2, __builtin_bit_cast(int, v)));
                if (fq == 0) rs[(size_t)(row0 + ai * 128 + m * 16) * 32 + u.pn * 4 + wc] = v; }
    }
};

template <int ACT>
__device__ __forceinline__ void store_tile_bf16(ACC_T, bf16* dst, int ld, int row0, int col0, int cmp = 0, unsigned* cnt = nullptr) {
#pragma unroll
    for (int ai = 0; ai < 2; ++ai)
#pragma unroll
        for (int m = 0; m < 4; ++m) {
            bf16* rowp = dst + (size_t)(row0 + ai * 128 + m * 16) * ld + col0;
#pragma unroll
            for (int bj = 0; bj < 2; ++bj) {
                f32x4 v0 = acc[ai][bj][m][0], v1 = acc[ai][bj][m][1];
                if (ACT == 1) {
#pragma unroll
                    for (int j = 0; j < 4; ++j) { v0[j] = siluf(v0[j]); v1[j] = siluf(v1[j]); } }
                if (ACT == 2) {
#pragma unroll
                    for (int j = 0; j < 4; ++j) { v0[j] = sigm(v0[j]); v1[j] = sigm(v1[j]); } }
                u32x4 w; w.x = pk2(v0[0], v0[1]); w.y = pk2(v0[2], v0[3]); w.z = pk2(v1[0], v1[1]); w.w = pk2(v1[2], v1[3]);
                if (cmp) { const u32x4 o_ = *(const u32x4*)(rowp + bj * 128); if (o_.x != w.x || o_.y != w.y || o_.z != w.z || o_.w != w.w) { atomicAdd(cnt, 1u);
                    float md = 0.f; const unsigned ow[4] = {o_.x, o_.y, o_.z, o_.w}, nw[4] = {w.x, w.y, w.z, w.w};
#pragma unroll
                    for (int q_ = 0; q_ < 4; ++q_) { md = fmaxf(md, fabsf(__uint_as_float(ow[q_] << 16) - __uint_as_float(nw[q_] << 16))); md = fmaxf(md, fabsf(__uint_as_float(ow[q_] & 0xffff0000u) - __uint_as_float(nw[q_] & 0xffff0000u))); }
                    atomicMax(cnt + 16, __float_as_uint(md)); } }
                else *(u32x4*)(rowp + bj * 128) = w;
            }
        }
}


__device__ __forceinline__ void store_tile_bf16_rt(ACC_T, bf16* dst, int ld, int row0, int col0, int act) {
    const float ks = act == 2 ? 0.0f : 1.0f, kx = act == 0 ? 1.0f : 0.0f;
#pragma unroll
    for (int ai = 0; ai < 2; ++ai)
#pragma unroll
        for (int m = 0; m < 4; ++m) {
            bf16* rowp = dst + (size_t)(row0 + ai * 128 + m * 16) * ld + col0;
#pragma unroll
            for (int bj = 0; bj < 2; ++bj) {
                f32x4 v0 = acc[ai][bj][m][0], v1 = acc[ai][bj][m][1];
#pragma unroll
                for (int j = 0; j < 4; ++j) {
                    const float s0 = sigm(v0[j]), s1 = sigm(v1[j]);
                    const float a0 = (ks * v0[j] + (1.0f - ks)) * s0, a1 = (ks * v1[j] + (1.0f - ks)) * s1;
                    v0[j] = act == 0 ? v0[j] : a0; v1[j] = act == 0 ? v1[j] : a1; }
                (void)kx;
                u32x4 w; w.x = pk2(v0[0], v0[1]); w.y = pk2(v0[2], v0[3]); w.z = pk2(v1[0], v1[1]); w.w = pk2(v1[2], v1[3]);
                *(u32x4*)(rowp + bj * 128) = w;
            }
        }
}
struct FourierOrder {
    int c;
    __device__ __forceinline__ bool next(int i, pg8::Unit& u) const { if (i > 0 || c >= 192) return false; u.pm = c & 1; u.pn = c >> 1; u.bz = 0; return true; }
    __device__ __forceinline__ const char* abase(const pg8::Gemm& g, const pg8::Unit& u) const { return (const char*)g.A + (size_t)u.pm * (size_t)512 * g.K; }
    __device__ __forceinline__ const char* bbase(const pg8::Gemm& g, const pg8::Unit& u) const { return (const char*)g.Bt + (size_t)u.pn * (size_t)512 * g.K; }
    __device__ __forceinline__ void a_ready(const pg8::Unit&) const {}
    __device__ __forceinline__ void done(const pg8::Unit&) const {}
};
struct EpiFourier {
    static constexpr bool PERM = true, AFTER_DRAIN = false; static constexpr int SCALE = 2;
    unsigned char* ws;
    __device__ __forceinline__ void prescale(f32x4 (&acc)[2][2][4][2], const pg8::Unit& u, int wr, int wc, int fr, int fq, LAS unsigned char* lds, int tid) const { col_prescale(acc, (const float*)(ws + WS_RS), u.pn, wc, fq, lds, tid); }
    __device__ __forceinline__ void operator()(ACC_T, const pg8::Unit& u, int wr, int wc, int fr, int fq) const {
        bf16* PQT = (bf16*)(ws + WS_PQT);
        const int t0 = u.pn * 256; int S, sbase; bf16* pq;
        if (t0 < TP) { S = 2048; const int b = t0 >> 11; sbase = b * 2048; pq = PQT + (size_t)b * 512 * 4096; }
        else { S = 8192; const int b = (t0 - TP) >> 13; sbase = TP + b * 8192; pq = PQT + (size_t)4 * 512 * 4096 + (size_t)b * 512 * 16384; }
        const unsigned Su = (unsigned)S, pos0 = (unsigned)(t0 - sbase + wc * 32 + 8 * fq);
#pragma unroll
        for (int ai = 0; ai < 2; ++ai)
#pragma unroll
            for (int m = 0; m < 4; ++m) {
                const int jj = 64 * wr + 16 * m + fr, z = jj > 64 ? 1 : 0, c = jj - 64 * z, rg = 128 * (2 * u.pm + ai); const bool sp = (jj == 0) || (jj == 64);
                const unsigned o1 = (unsigned)(z * 512 + rg + c) * Su + pos0, o2 = (unsigned)((sp ? 512 + c : z * 512 + 128 - c) + rg) * Su + pos0;
                const unsigned keep = sp ? 0u : 0xffffffffu, sg = z ? 0x80008000u : 0u;
#pragma unroll
                for (int bj = 0; bj < 2; ++bj) { const f32x4 v0 = acc[ai][bj][m][0], v1 = acc[ai][bj][m][1];
                    u32x4 w; w.x = pk2(v0[0], v0[1]); w.y = pk2(v0[2], v0[3]); w.z = pk2(v1[0], v1[1]); w.w = pk2(v1[2], v1[3]);
                    *(u32x4*)(pq + o1 + bj * 128) = w;
                    u32x4 w2; w2.x = (w.x ^ sg) & keep; w2.y = (w.y ^ sg) & keep; w2.z = (w.z ^ sg) & keep; w2.w = (w.w ^ sg) & keep;
                    *(u32x4*)(pq + o2 + bj * 128) = w2; }
            }
    }
};
struct EpiPlain {
    static constexpr bool PERM = true, AFTER_DRAIN = false; static constexpr int SCALE = 1;
    unsigned char* ws;
    __device__ __forceinline__ void prescale(f32x4 (&acc)[2][2][4][2], const pg8::Unit& u, int wr, int wc, int fr, int fq, LAS unsigned char* lds, int tid) const { row_prescale(acc, (const float*)(ws + WS_RS), u.pm, wr, fr, lds, tid); }
    __device__ __forceinline__ void operator()(ACC_T, const pg8::Unit& u, int wr, int wc, int fr, int fq) const {
        const int pn = u.pn, seg = pn < 6 ? 0 : pn < 12 ? 1 : pn < 20 ? 2 : 3, pn0 = seg == 0 ? 0 : seg == 1 ? 6 : seg == 2 ? 12 : 20;
        const size_t off = seg == 0 ? WS_VV : seg == 1 ? WS_GO : seg == 2 ? WS_SA : WS_SB;
        store_tile_bf16<0>(acc, (bf16*)(ws + off), seg < 2 ? HG : D, u.pm * 256 + wr * 64 + fr, (pn - pn0) * 256 + wc * 32 + 8 * fq);
    }
};
struct EpiMixIn {
    static constexpr bool PERM = true, AFTER_DRAIN = false; static constexpr int SCALE = 1;
    unsigned char* ws; int l; int cmp; unsigned* cnt;
    __device__ __forceinline__ void prescale(f32x4 (&acc)[2][2][4][2], const pg8::Unit& u, int wr, int wc, int fr, int fq, LAS unsigned char* lds, int tid) const { row_prescale(acc, (const float*)(ws + WS_RS), u.pm, wr, fr, lds, tid); }
    __device__ __forceinline__ void operator()(ACC_T, const pg8::Unit& u, int wr, int wc, int fr, int fq) const {
        bf16* PQT = (bf16*)(ws + WS_PQT); bf16* QS = (bf16*)(ws + WS_QS); bf16* VV = (bf16*)(ws + WS_VV); bf16* GO = (bf16*)(ws + WS_GO); bf16* SA = (bf16*)(ws + WS_SA); bf16* SB = (bf16*)(ws + WS_SB);
        float* LF = (float*)(ws + WS_LF); const float* lbf = (const float*)(ws + WS_LB) + (size_t)l * HG; const float* lbb = lbf + (size_t)4 * HG;
        const int pn = u.pn + 2, row0 = u.pm * 256 + wr * 64 + fr, cw = wc * 32 + 8 * fq;
        if (pn >= 8 && pn < 20) {
            const int dir = pn >= 14, col0 = (pn - (dir ? 14 : 8)) * 256 + cw;
            const float* lb = dir ? lbb : lbf; float* dst = LF + (size_t)dir * T * HG;
            f32x4 lbv[2][2];
#pragma unroll
            for (int bj = 0; bj < 2; ++bj)
#pragma unroll
                for (int n = 0; n < 2; ++n) lbv[bj][n] = *(const f32x4*)(lb + col0 + bj * 128 + 4 * n);
#pragma unroll
            for (int ai = 0; ai < 2; ++ai)
#pragma unroll
                for (int m = 0; m < 4; ++m) {
                    float* rowp = dst + (size_t)(row0 + ai * 128 + m * 16) * HG + col0;
#pragma unroll
                    for (int bj = 0; bj < 2; ++bj)
#pragma unroll
                        for (int n = 0; n < 2; ++n) {
                            const f32x4 z = acc[ai][bj][m][n]; f32x4 o;
#pragma unroll
                            for (int j = 0; j < 4; ++j) { const float l = lbv[bj][n][j]; const float f = l + (1.0f - l) * sigm(z[j]); o[j] = __logf(fmaxf(f, 1e-30f)); }
                            if (cmp) { const f32x4 o_ = *(const f32x4*)(rowp + bj * 128 + 4 * n); if (o_[0] != o[0] || o_[1] != o[1] || o_[2] != o[2] || o_[3] != o[3]) atomicAdd(cnt + 2, 1u); } else
                            *(f32x4*)(rowp + bj * 128 + 4 * n) = o;
                        }
                }
        } else {
            store_tile_bf16_rt(acc, (bf16*)(ws + WS_QS), HG, row0, (pn - 2) * 256 + cw, 1);
        }
    }
};


struct EpiRaw {
    static constexpr bool PERM = true, AFTER_DRAIN = false; static constexpr int SCALE = 0;
    unsigned char* ws;
    __device__ __forceinline__ void operator()(ACC_T, const pg8::Unit& u, int wr, int wc, int fr, int fq) const {
        store_tile_bf16<0>(acc, (bf16*)(ws + WS_PQT), NIN, u.pm * 256 + wr * 64 + fr, u.pn * 256 + wc * 32 + 8 * fq);
    }
};
struct EpiDft {
    static constexpr bool PERM = true, AFTER_DRAIN = false; static constexpr int SCALE = 0;
    unsigned char* ws; int sbase0, sstride; float scale;
    __device__ __forceinline__ void operator()(ACC_T, const pg8::Unit& u, int wr, int wc, int fr, int fq) const {
        bf16* Y = (bf16*)(ws + WS_YY);
        const int row0 = sbase0 + u.bz * sstride + u.pm * 256 + wr * 64 + fr, col0 = u.pn * 256 + wc * 32 + 8 * fq;
#pragma unroll
        for (int ai = 0; ai < 2; ++ai)
#pragma unroll
            for (int m = 0; m < 4; ++m) {
                bf16* rowp = Y + (size_t)(row0 + ai * 128 + m * 16) * FW + col0;
#pragma unroll
                for (int bj = 0; bj < 2; ++bj) {
                    const f32x4 v0 = acc[ai][bj][m][0] * scale, v1 = acc[ai][bj][m][1] * scale;
                    u32x4 w; w.x = pk2(v0[0], v0[1]); w.y = pk2(v0[2], v0[3]); w.z = pk2(v1[0], v1[1]); w.w = pk2(v1[2], v1[3]);
                    *(u32x4*)(rowp + bj * 128) = w;
                }
            }
    }
};

struct DftOrder {
    int nM, nb, G, c; size_t bstride, astride;
    __device__ __forceinline__ bool next(int i, pg8::Unit& u) const {
        const long L = (long)i * G + c; const int per = nM * 2; if (L >= (long)nb * per) return false;
        u.bz = (int)(L / per); const int r = (int)(L % per); u.pm = r >> 1; u.pn = r & 1; return true;
    }
    __device__ __forceinline__ const char* abase(const pg8::Gemm& g, const pg8::Unit& u) const { return (const char*)g.A + (size_t)(u.bz & 1) * astride + (size_t)u.pm * (size_t)512 * g.K; }
    __device__ __forceinline__ const char* bbase(const pg8::Gemm& g, const pg8::Unit& u) const { return (const char*)g.Bt + (size_t)u.bz * bstride + (size_t)u.pn * (size_t)512 * g.K; }
    __device__ __forceinline__ void a_ready(const pg8::Unit&) const {}
    __device__ __forceinline__ void done(const pg8::Unit&) const {}
};
struct EpiDftH {
    static constexpr bool PERM = true, AFTER_DRAIN = false; static constexpr int SCALE = 0;
    unsigned char* ws; int rbase0, rstride; float scale;
    __device__ __forceinline__ void operator()(ACC_T, const pg8::Unit& u, int wr, int wc, int fr, int fq) const {
        float* AB = (float*)(ws + WS_U) + (size_t)(u.bz & 1) * (T / 2) * FW;
        const int row0 = rbase0 + (u.bz >> 1) * rstride + u.pm * 256 + wr * 64 + fr, col0 = u.pn * 256 + wc * 32 + 8 * fq;
#pragma unroll
        for (int ai = 0; ai < 2; ++ai)
#pragma unroll
            for (int m = 0; m < 4; ++m) {
                float* rowp = AB + (size_t)(row0 + ai * 128 + m * 16) * FW + col0;
#pragma unroll
                for (int bj = 0; bj < 2; ++bj) { *(f32x4*)(rowp + bj * 128) = acc[ai][bj][m][0] * scale; *(f32x4*)(rowp + bj * 128 + 4) = acc[ai][bj][m][1] * scale; }
            }
    }
};

struct EpiBranchA {
    static constexpr bool PERM = true, AFTER_DRAIN = false; static constexpr int SCALE = 0;
    unsigned char* ws;
    __device__ __forceinline__ void operator()(ACC_T, const pg8::Unit& u, int wr, int wc, int fr, int fq) const {
        const bf16* SA = (const bf16*)(ws + WS_SA); bf16* P = (bf16*)(ws + WS_PP);
        const int row0 = u.pm * 256 + wr * 64 + fr, col0 = u.pn * 256 + wc * 32 + 8 * fq;
#pragma unroll
        for (int ai = 0; ai < 2; ++ai) {
            u32x4 g[4][2];
#pragma unroll
            for (int m = 0; m < 4; ++m)
#pragma unroll
                for (int bj = 0; bj < 2; ++bj) g[m][bj] = *(const u32x4*)(SA + (size_t)(row0 + ai * 128 + m * 16) * D + col0 + bj * 128);
#pragma unroll
            for (int m = 0; m < 4; ++m) { const size_t off = (size_t)(row0 + ai * 128 + m * 16) * D + col0;
#pragma unroll
                for (int bj = 0; bj < 2; ++bj) { const u32x4 gv = g[m][bj];
                    const f32x4 g0 = {sigm(__uint_as_float(gv.x << 16)), sigm(__uint_as_float(gv.x & 0xffff0000u)), sigm(__uint_as_float(gv.y << 16)), sigm(__uint_as_float(gv.y & 0xffff0000u))};
                    const f32x4 g1 = {sigm(__uint_as_float(gv.z << 16)), sigm(__uint_as_float(gv.z & 0xffff0000u)), sigm(__uint_as_float(gv.w << 16)), sigm(__uint_as_float(gv.w & 0xffff0000u))};
                    const f32x4 v0 = g0 * acc[ai][bj][m][0], v1 = g1 * acc[ai][bj][m][1];
                    u32x4 w; w.x = pk2(v0[0], v0[1]); w.y = pk2(v0[2], v0[3]); w.z = pk2(v1[0], v1[1]); w.w = pk2(v1[2], v1[3]);
                    *(u32x4*)(P + off + bj * 128) = w; } }
        }
    }
};
struct EpiBranchB {
    static constexpr bool PERM = true, AFTER_DRAIN = false; static constexpr int SCALE = 0;
    unsigned char* ws;
    __device__ __forceinline__ void operator()(ACC_T, const pg8::Unit& u, int wr, int wc, int fr, int fq) const {
        const bf16* SB = (const bf16*)(ws + WS_SB); const bf16* P = (const bf16*)(ws + WS_PP); bf16* MG = (bf16*)(ws + WS_MG);
        const int row0 = u.pm * 256 + wr * 64 + fr, col0 = u.pn * 256 + wc * 32 + 8 * fq;
#pragma unroll
        for (int ai = 0; ai < 2; ++ai)
#pragma unroll
            for (int mp = 0; mp < 2; ++mp) {
                u32x4 g[2][2], pp[2][2];
#pragma unroll
                for (int mm = 0; mm < 2; ++mm) { const size_t off = (size_t)(row0 + ai * 128 + (2 * mp + mm) * 16) * D + col0;
#pragma unroll
                    for (int bj = 0; bj < 2; ++bj) { g[mm][bj] = *(const u32x4*)(SB + off + bj * 128); pp[mm][bj] = *(const u32x4*)(P + off + bj * 128); } }
#pragma unroll
                for (int mm = 0; mm < 2; ++mm) { const int m = 2 * mp + mm; const size_t off = (size_t)(row0 + ai * 128 + m * 16) * D + col0;
#pragma unroll
                    for (int bj = 0; bj < 2; ++bj) { const u32x4 gv = g[mm][bj];
                        const f32x4 g0 = {sigm(__uint_as_float(gv.x << 16)), sigm(__uint_as_float(gv.x & 0xffff0000u)), sigm(__uint_as_float(gv.y << 16)), sigm(__uint_as_float(gv.y & 0xffff0000u))};
                        const f32x4 g1 = {sigm(__uint_as_float(gv.z << 16)), sigm(__uint_as_float(gv.z & 0xffff0000u)), sigm(__uint_as_float(gv.w << 16)), sigm(__uint_as_float(gv.w & 0xffff0000u))};
                        const u32x4 pv = pp[mm][bj];
                        const f32x4 q0 = {__uint_as_float(pv.x << 16), __uint_as_float(pv.x & 0xffff0000u), __uint_as_float(pv.y << 16), __uint_as_float(pv.y & 0xffff0000u)};
                        const f32x4 q1 = {__uint_as_float(pv.z << 16), __uint_as_float(pv.z & 0xffff0000u), __uint_as_float(pv.w << 16), __uint_as_float(pv.w & 0xffff0000u)};
                        const f32x4 v0 = q0 + g0 * acc[ai][bj][m][0], v1 = q1 + g1 * acc[ai][bj][m][1];
                        u32x4 w; w.x = pk2(v0[0], v0[1]); w.y = pk2(v0[2], v0[3]); w.z = pk2(v1[0], v1[1]); w.w = pk2(v1[2], v1[3]);
                        *(u32x4*)(MG + off + bj * 128) = w; } }
            }
    }
};

typedef const __attribute__((address_space(4))) Args ArgsK; typedef ArgsK* ArgsP;
struct Ctx { LAS unsigned char* lds; int tid, lane, wave, G, vcu, gw, NGW; };

__device__ __forceinline__ void conv_item(const float* W, int K, int Nsrc, int nsrc0, bf16* WT, int nrow0, int k0, LAS float* scr, int lane, const float* gk = nullptr) {
    { f32x4 v[8]; const int c4 = (lane & 7) * 4;
#pragma unroll
      for (int i = 0; i < 8; ++i) v[i] = *(const f32x4*)(W + (size_t)(k0 + 8 * i + (lane >> 3)) * Nsrc + nsrc0 + c4);
      if (gk != nullptr) {
#pragma unroll
        for (int i = 0; i < 8; ++i) v[i] *= gk[k0 + 8 * i + (lane >> 3)]; }
#pragma unroll
      for (int i = 0; i < 8; ++i) { LAS float* d = scr + (8 * i + (lane >> 3)) * 33 + c4; d[0] = v[i].x; d[1] = v[i].y; d[2] = v[i].z; d[3] = v[i].w; } }
    LDS_WAIT();
    const int c = lane & 7;
#pragma unroll
    for (int j = 0; j < 4; ++j) { const int n = (lane >> 3) + 8 * j; const LAS float* s = scr + (8 * c) * 33 + n;
        u32x4 o; o.x = pk2(s[0 * 33], s[1 * 33]); o.y = pk2(s[2 * 33], s[3 * 33]); o.z = pk2(s[4 * 33], s[5 * 33]); o.w = pk2(s[6 * 33], s[7 * 33]);
        *(u32x4*)(WT + (size_t)(nrow0 + n) * K + k0 + 8 * c) = o; }
    LDS_WAIT();
}

__device__ __forceinline__ void conv_fold_tile(const Ctx& C, const float* win, bf16* WIN, int tile, const float* gk) {
    LAS float* wt = (LAS float*)C.lds;
    LAS f32x2* tab = (LAS f32x2*)(C.lds + 33280);
    const int kb = tile >> 2, g = tile & 3, k0 = kb * 64;
    __syncthreads();
    for (int e = C.tid; e < 64 * 128; e += 512) { const int kk = e >> 7, c = e & 127; wt[kk * 129 + c] = win[(size_t)(k0 + kk) * 12288 + g * 128 + c] * gk[k0 + kk]; }
    if (C.tid < 128) { const float s = 0.08838834764831845f; tab[C.tid] = (f32x2){cospif((float)C.tid * (1.0f / 64.0f)) * s, sinpif((float)C.tid * (1.0f / 64.0f)) * s}; }
    __syncthreads();
    const int k = C.lane, jb = 16 * C.wave;
    float aP[16], aQ[16];
#pragma unroll
    for (int j = 0; j < 16; ++j) { aP[j] = 0.f; aQ[j] = 0.f; }
    for (int c = 0; c < 128; ++c) {
        const float w = wt[k * 129 + c];
#pragma unroll
        for (int j = 0; j < 16; ++j) { const f32x2 t = tab[(c * (jb + j)) & 127]; aP[j] += w * t.x; aQ[j] += w * t.y; }
    }
#pragma unroll
    for (int j = 0; j < 16; ++j) {
        int fo = jb + j; asm volatile("" : "+v"(fo));
        if (fo <= 64) WIN[(size_t)(128 * g + fo) * D + k0 + k] = (bf16)(pk2(aP[j], 0.f) & 0xffffu);
        if (fo >= 1 && fo <= 63) WIN[(size_t)(128 * g + 64 + fo) * D + k0 + k] = (bf16)(pk2(aQ[j], 0.f) & 0xffffu);
    }
}
__device__ __forceinline__ void phase_wconv(const Ctx& C, const ArgsK& a, int l, int groups, int rank, int count) {
    if (rank < 0) return;
    unsigned char* ws = a.ws;
    const float* w1i = a.in[3] + (size_t)l * D * 2 * FF;  const float* w1d = a.in[4] + (size_t)l * FF * D;
    const float* win = a.in[6] + (size_t)l * D * 12288;   const float* wfo = a.in[9] + (size_t)l * FW * D;
    const float* who = a.in[10] + (size_t)l * HG * D;     const float* wou = a.in[11] + (size_t)l * D * D;
    const float* w2i = a.in[13] + (size_t)l * D * 2 * FF; const float* w2d = a.in[14] + (size_t)l * FF * D;
    for (int tile = rank; tile < ((groups & 1) ? 128 : 0); tile += count) conv_fold_tile(C, win, (bf16*)(ws + WS_WIN), tile, a.in[5] + (size_t)l * D);
    __syncthreads();
    LAS float* scr = (LAS float*)(C.lds + C.wave * 16384);
    constexpr int I_WI = 32 * 344, I_WD = 86 * 64, I_IN = 32 * 368, I_FO = 8 * 64, I_HO = 24 * 64, I_OU = 32 * 64;
    constexpr int NIT = 2 * I_WI + 2 * I_WD + I_IN + I_FO + I_HO + I_OU;
    for (int it = rank * 8 + C.wave; it < NIT; it += count * 8) {
        int r = it;
        { const bool g1 = (r < I_WI) || (r >= 2 * I_WI && r < 2 * I_WI + I_WD) || (r >= 2 * I_WI + 2 * I_WD && r < 2 * I_WI + 2 * I_WD + I_IN); if (!((g1 ? 1 : 2) & groups)) continue; }
        if (r < 2 * I_WI) { const bool second = r >= I_WI; if (second) r -= I_WI;
            const int kb = r / 344, nb = r % 344, n0 = 32 * nb, p = n0 >> 8, j = n0 & 255;
            const int sc = j < 128 ? 128 * p + j : FF + 128 * p + (j - 128);
            conv_item(second ? w2i : w1i, D, 2 * FF, sc, (bf16*)(ws + (second ? WS_W2I : WS_W1I)), n0, 64 * kb, scr, C.lane, a.in[second ? 12 : 2] + (size_t)l * D); continue; }
        r -= 2 * I_WI;
        if (r < 2 * I_WD) { const bool second = r >= I_WD; if (second) r -= I_WD;
            const int kb = r / 64, nb = r % 64;
            conv_item(second ? w2d : w1d, FF, D, 32 * nb, (bf16*)(ws + (second ? WS_W2D : WS_W1D)), 32 * nb, 64 * kb, scr, C.lane); continue; }
        r -= 2 * I_WD;
        if (r < I_IN) { const int kb = r / 368, nb = r % 368; conv_item(win, D, 12288, 512 + 32 * nb, (bf16*)(ws + WS_WIN), 512 + 32 * nb, 64 * kb, scr, C.lane, a.in[5] + (size_t)l * D); continue; }
        r -= I_IN;
        if (r < I_FO) { const int kb = r / 64, nb = r % 64; conv_item(wfo, FW, D, 32 * nb, (bf16*)(ws + WS_WFO), 32 * nb, 64 * kb, scr, C.lane); continue; }
        r -= I_FO;
        if (r < I_HO) { const int kb = r / 64, nb = r % 64; conv_item(who, HG, D, 32 * nb, (bf16*)(ws + WS_WHO), 32 * nb, 64 * kb, scr, C.lane); continue; }
        r -= I_HO;
        { const int kb = r / 64, nb = r % 64; conv_item(wou, D, D, 32 * nb, (bf16*)(ws + WS_WOU), 32 * nb, 64 * kb, scr, C.lane); }
    }
}

constexpr int Q_WI = 32 * 344, Q_WD = 86 * 64, Q_IN = 32 * 368, Q_NIT = Q_WI + Q_WD + Q_IN, CONV_NCH = 128 + (Q_NIT + 127) / 128;
__device__ __forceinline__ void conv_chunk(const Ctx& C, const ArgsK& a, int l, int c) {
    unsigned char* ws = a.ws;
    const float* win = a.in[6] + (size_t)l * D * 12288;
    if (c < 128) { conv_fold_tile(C, win, (bf16*)(ws + WS_WIN), c, a.in[5] + (size_t)l * D); return; }
    const float* w1i = a.in[3] + (size_t)l * D * 2 * FF;  const float* w1d = a.in[4] + (size_t)l * FF * D;
    LAS float* scr = (LAS float*)(C.lds + C.wave * 16384);
    const int base = (c - 128) * 128, end = base + 128 < Q_NIT ? base + 128 : Q_NIT;
    for (int r0 = base + C.wave; r0 < end; r0 += 8) { int r = r0;
        if (r < Q_WI) { const int kb = r / 344, nb = r % 344, n0 = 32 * nb, p = n0 >> 8, j = n0 & 255; const int sc = j < 128 ? 128 * p + j : FF + 128 * p + (j - 128);
            conv_item(w1i, D, 2 * FF, sc, (bf16*)(ws + WS_W1I), n0, 64 * kb, scr, C.lane, a.in[2] + (size_t)l * D); continue; }
        r -= Q_WI;
        if (r < Q_WD) { const int kb = r / 64, nb = r % 64; conv_item(w1d, FF, D, 32 * nb, (bf16*)(ws + WS_W1D), 32 * nb, 64 * kb, scr, C.lane); continue; }
        r -= Q_WD;
        { const int kb = r / 368, nb = r % 368; conv_item(win, D, 12288, 512 + 32 * nb, (bf16*)(ws + WS_WIN), 512 + 32 * nb, 64 * kb, scr, C.lane, a.in[5] + (size_t)l * D); }
    }
}
__device__ __forceinline__ int wq_grab(const Ctx& C, unsigned* ctr, unsigned* stopw, unsigned stop_at) {
    volatile LAS int* slot = (volatile LAS int*)(C.lds + LDS_BAR_OFF + 32);
    __syncthreads();
    if (C.tid == 0) { int v = -1;
        if (!(stop_at && __hip_atomic_load(stopw, __ATOMIC_RELAXED, __HIP_MEMORY_SCOPE_AGENT) >= stop_at)) v = (int)__hip_atomic_fetch_add(ctr, 1u, __ATOMIC_RELAXED, __HIP_MEMORY_SCOPE_AGENT);
        *slot = v; }
    __syncthreads();
    return __builtin_amdgcn_readfirstlane(*slot);
}
constexpr int Q2_FO = 8 * 64, Q2_HO = 24 * 64, Q2_OU = 32 * 64, CONV2_NCH = (Q_WI + Q_WD + Q2_FO + Q2_HO + Q2_OU) / 128;
static_assert((Q_WI % 128) == 0 && (Q_WD % 128) == 0 && (Q2_FO % 128) == 0 && (Q2_HO % 128) == 0 && (Q2_OU % 128) == 0, "chunks never straddle two weights");
__device__ __forceinline__ void conv_chunk2(const Ctx& C, const ArgsK& a, int l, int c) {
    unsigned char* ws = a.ws;
    LAS float* scr = (LAS float*)(C.lds + C.wave * 16384);
    for (int r0 = c * 128 + C.wave; r0 < (c + 1) * 128; r0 += 8) { int r = r0;
        if (r < Q_WI) { const int kb = r / 344, nb = r % 344, n0 = 32 * nb, p = n0 >> 8, j = n0 & 255; const int sc = j < 128 ? 128 * p + j : FF + 128 * p + (j - 128);
            conv_item(a.in[13] + (size_t)l * D * 2 * FF, D, 2 * FF, sc, (bf16*)(ws + WS_W2I), n0, 64 * kb, scr, C.lane, a.in[12] + (size_t)l * D); continue; }
        r -= Q_WI;
        if (r < Q_WD) { const int kb = r / 64, nb = r % 64; conv_item(a.in[14] + (size_t)l * FF * D, FF, D, 32 * nb, (bf16*)(ws + WS_W2D), 32 * nb, 64 * kb, scr, C.lane); continue; }
        r -= Q_WD;
        if (r < Q2_FO) { const int kb = r / 64, nb = r % 64; conv_item(a.in[9] + (size_t)l * FW * D, FW, D, 32 * nb, (bf16*)(ws + WS_WFO), 32 * nb, 64 * kb, scr, C.lane); continue; }
        r -= Q2_FO;
        if (r < Q2_HO) { const int kb = r / 64, nb = r % 64; conv_item(a.in[10] + (size_t)l * HG * D, HG, D, 32 * nb, (bf16*)(ws + WS_WHO), 32 * nb, 64 * kb, scr, C.lane); continue; }
        r -= Q2_HO;
        { const int kb = r / 64, nb = r % 64; conv_item(a.in[11] + (size_t)l * D * D, D, D, 32 * nb, (bf16*)(ws + WS_WOU), 32 * nb, 64 * kb, scr, C.lane); }
    }
}

__device__ __forceinline__ void phase_prologue(const Ctx& C, const ArgsK& a) {
    const int gt = C.vcu * 512 + C.tid, NT = C.G * 512;
    float* lb = (float*)(a.ws + WS_LB); const float* lg = a.in[7];
    for (int i = gt; i < 2 * HG; i += NT) {
        const int d = i / HG, c = i % HG; float z[4], mx = -3.0e38f;
#pragma unroll
        for (int l = 0; l < 4; ++l) { z[l] = lg[(size_t)(d * 4 + l) * HG + c]; mx = fmaxf(mx, z[l]); }
        float s = 0.f;
#pragma unroll
        for (int l = 0; l < 4; ++l) { z[l] = expf(z[l] - mx); s += z[l]; }
        const float p0 = z[0] / s; float cum = 0.f;
#pragma unroll
        for (int l = 0; l < 4; ++l) { cum += z[l] / s; lb[(size_t)(d * 4 + l) * HG + c] = fmaxf(cum - p0, 0.f); }
    }
    bf16* D8 = (bf16*)(a.ws + WS_DM8);
    for (size_t i = gt; i < (size_t)2 * 4096 * 8192 / 8; i += NT) {
        const int z = (int)(i >> 22), k = (int)(i >> 10) & 4095, n0 = (int)(i & 1023) * 8; float v[8];
#pragma unroll
        for (int j = 0; j < 8; ++j) { const int m = (k * (n0 + j)) & 8191; const float x = (float)m * (1.0f / 4096.0f); v[j] = z ? -sinpif(x) : cospif(x); }
        u32x4 o; o.x = pk2(v[0], v[1]); o.y = pk2(v[2], v[3]); o.z = pk2(v[4], v[5]); o.w = pk2(v[6], v[7]);
        *(u32x4*)(D8 + i * 8) = o;
    }
    bf16* D2 = (bf16*)(a.ws + WS_DM2);
    for (size_t i = gt; i < (size_t)2 * 1024 * 2048 / 8; i += NT) {
        const int z = (int)(i >> 18), k = (int)(i >> 8) & 1023, n0 = (int)(i & 255) * 8; float v[8];
#pragma unroll
        for (int j = 0; j < 8; ++j) { const int m = (k * (n0 + j)) & 2047; const float x = (float)m * (1.0f / 1024.0f); v[j] = z ? -sinpif(x) : cospif(x); }
        u32x4 o; o.x = pk2(v[0], v[1]); o.y = pk2(v[2], v[3]); o.z = pk2(v[4], v[5]); o.w = pk2(v[6], v[7]);
        *(u32x4*)(D2 + i * 8) = o;
    }
}

__device__ __forceinline__ void phase_norm(const Ctx& C, const float* xp, const float* xs, const float* gain, bf16* U) {
    f32x4 g[8];
#pragma unroll
    for (int j = 0; j < 8; ++j) g[j] = ((const f32x4*)gain)[C.lane + 64 * j];
    for (int m = C.gw; m < T; m += C.NGW) {
        const f32x4* xr = (const f32x4*)(m < TP ? xp + (size_t)m * D : xs + (size_t)(m - TP) * D) + C.lane;
        f32x4 v[8]; float s = 0.f;
#pragma unroll
        for (int j = 0; j < 8; ++j) { v[j] = xr[64 * j]; s += (v[j].x * v[j].x + v[j].y * v[j].y) + (v[j].z * v[j].z + v[j].w * v[j].w); }
        const float r = 1.0f / sqrtf(wave_sum(s, C.lane) * (1.0f / D) + EPS);
        u32x2* o = (u32x2*)(U + (size_t)m * D) + C.lane;
#pragma unroll
        for (int j = 0; j < 8; ++j) { u32x2 w; w.x = pk2(v[j].x * r * g[j].x, v[j].y * r * g[j].y); w.y = pk2(v[j].z * r * g[j].z, v[j].w * r * g[j].w); o[64 * j] = w; }
    }
}
__device__ __forceinline__ void phase_cast0(const Ctx& C, const float* xp, const float* xs, bf16* U, float* rs) {
    for (int m = C.gw; m < T; m += C.NGW) {
        const f32x4* xr = (const f32x4*)(m < TP ? xp + (size_t)m * D : xs + (size_t)(m - TP) * D) + C.lane;
        f32x4 v[8]; float s = 0.f;
#pragma unroll
        for (int j = 0; j < 8; ++j) { v[j] = xr[64 * j]; s += (v[j].x * v[j].x + v[j].y * v[j].y) + (v[j].z * v[j].z + v[j].w * v[j].w); }
        s = wave_sum(s, C.lane);
        u32x2* o = (u32x2*)(U + (size_t)m * D) + C.lane;
#pragma unroll
        for (int j = 0; j < 8; ++j) { u32x2 w; w.x = pk2(v[j].x, v[j].y); w.y = pk2(v[j].z, v[j].w); o[64 * j] = w; }
        if (C.lane < 32) rs[(size_t)m * 32 + C.lane] = C.lane == 0 ? s : 0.f;
    }
}
template <bool OUT_F32>
__device__ __forceinline__ void phase_norm16(const Ctx& C, const bf16* x16, const float* gain, bf16* U, float* out) {
    f32x4 g[8];
#pragma unroll
    for (int j = 0; j < 4; ++j) { g[2 * j] = ((const f32x4*)gain)[2 * (C.lane + 64 * j)]; g[2 * j + 1] = ((const f32x4*)gain)[2 * (C.lane + 64 * j) + 1]; }
    for (int m = C.gw; m < T; m += C.NGW) {
        const u32x4* xr = (const u32x4*)(x16 + (size_t)m * D) + C.lane;
        u32x4 pv[4]; f32x4 v[8]; float s = 0.f;
#pragma unroll
        for (int j = 0; j < 4; ++j) pv[j] = xr[64 * j];
#pragma unroll
        for (int j = 0; j < 4; ++j) {
            v[2 * j] = (f32x4){__uint_as_float(pv[j].x << 16), __uint_as_float(pv[j].x & 0xffff0000u), __uint_as_float(pv[j].y << 16), __uint_as_float(pv[j].y & 0xffff0000u)};
            v[2 * j + 1] = (f32x4){__uint_as_float(pv[j].z << 16), __uint_as_float(pv[j].z & 0xffff0000u), __uint_as_float(pv[j].w << 16), __uint_as_float(pv[j].w & 0xffff0000u)}; }
#pragma unroll
        for (int j = 0; j < 8; ++j) s += (v[j].x * v[j].x + v[j].y * v[j].y) + (v[j].z * v[j].z + v[j].w * v[j].w);
        const float r = 1.0f / sqrtf(wave_sum(s, C.lane) * (1.0f / D) + EPS);
        if constexpr (OUT_F32) { f32x4* o = (f32x4*)(out + (size_t)m * D) + 2 * C.lane;
#pragma unroll
            for (int j = 0; j < 4; ++j) { o[128 * j] = v[2 * j] * r * g[2 * j]; o[128 * j + 1] = v[2 * j + 1] * r * g[2 * j + 1]; }
        } else { u32x4* o = (u32x4*)(U + (size_t)m * D) + C.lane;
#pragma unroll
            for (int j = 0; j < 4; ++j) { const f32x4 a0 = v[2 * j] * r * g[2 * j], a1 = v[2 * j + 1] * r * g[2 * j + 1];
                u32x4 w; w.x = pk2(a0.x, a0.y); w.y = pk2(a0.z, a0.w); w.z = pk2(a1.x, a1.y); w.w = pk2(a1.z, a1.w); o[64 * j] = w; } }
    }
}


typedef float f32x16 __attribute__((ext_vector_type(16)));
__device__ __forceinline__ void scan_item(const Ctx& C, const float* LFd, const bf16* QS, const bf16* VV, bf16* Oraw, int start, int len, int head, int dir, int mode, float* Ebuf, float* Lbuf, int lseg) {
    constexpr int PQ = 272, PK = 144;
    LAS unsigned char* const lds = C.lds;
    LAS unsigned char* const QD = lds, * const KD = lds + 17408, * const KDT = lds + 34816, * const VT = lds + 53248, * const PP_ = lds + 71680, * const SRT = lds + 80896;
    LAS float* const sO = (LAS float*)lds;
    LAS float* const sT = (LAS float*)(lds + 115712); LAS float* const sR = sT + 512; LAS float* const sB63 = sR + 128; LAS float* const sD = sB63 + 128; LAS float* const sE = sD + 128; LAS float* const sER = sE + 128;
    const int w = C.wave, p = w >> 1;
    asm volatile("s_waitcnt vmcnt(0)" ::: "memory"); __syncthreads();
    f32x16 S0, S1;
#pragma unroll
    for (int i = 0; i < 16; ++i) { S0[i] = 0.f; S1[i] = 0.f; }
    if (mode == 2 && lseg > 0) {
        const int ln = C.lane, hh = ln >> 5, vt = w & 3;
        int nseg = lseg; asm volatile("" : "+s"(nseg));
        for (int js = 0; js < nseg; ++js) {
            const float* Ej = Ebuf + (size_t)js * 16384; const float* Lj = Lbuf + js * 128;
            float lv[2][16], ev[2][16];
#pragma unroll
            for (int j = 0; j < 2; ++j) { const int kt = 2 * (w >> 2) + j;
#pragma unroll
                for (int i = 0; i < 16; ++i) lv[j][i] = __hip_atomic_load(Lj + 32 * kt + (i & 3) + 8 * (i >> 2) + 4 * hh, __ATOMIC_RELAXED, __HIP_MEMORY_SCOPE_AGENT); }
#pragma unroll
            for (int j = 0; j < 2; ++j) { const int kt = 2 * (w >> 2) + j; const float* tp = Ej + ((kt * 4 + vt) * 16) * 64 + ln;
#pragma unroll
                for (int i = 0; i < 16; ++i) ev[j][i] = __hip_atomic_load(tp + i * 64, __ATOMIC_RELAXED, __HIP_MEMORY_SCOPE_AGENT); }
#pragma unroll
            for (int i = 0; i < 16; ++i) { S0[i] = __expf(lv[0][i]) * S0[i] + ev[0][i]; S1[i] = __expf(lv[1][i]) * S1[i] + ev[1][i]; }
        }
    }
    float lsum = 0.f;
    const long st_ = dir == 0 ? (long)HG : -(long)HG;
    const int nch = len / 64;
    float nlf[16]; unsigned nv[8];
#define SCAN_LOAD(cc) do { const int tk0 = dir == 0 ? start + 64 * (cc) : start + len - 64 - 64 * (cc); \
        const size_t idx0 = (size_t)(dir == 0 ? tk0 + 16 * p : tk0 + 63 - 16 * p) * HG + head * 128 + k; const float* lp = LFd + idx0; const bf16* vp = VV + idx0; \
        _Pragma("unroll") for (int i = 0; i < 16; ++i) { nlf[i] = *lp; lp += st_; } \
        _Pragma("unroll") for (int i = 0; i < 8; ++i) { nv[i] = (unsigned)vp[0] | ((unsigned)vp[st_] << 16); vp += 2 * st_; } } while (0)
    int lane = C.lane, k = (w & 1) * 64 + lane, h = lane >> 5, l31 = lane & 31;
    SCAN_LOAD(0);
    for (int c = 0; c < nch; ++c) {
        { int l_ = C.lane; asm volatile("" : "+v"(l_)); lane = l_; k = (w & 1) * 64 + lane; h = lane >> 5; l31 = lane & 31; }
        const int tok0 = dir == 0 ? start + 64 * c : start + len - 64 - 64 * c;
        float bl[16]; float bs = 0.f; unsigned nq[8];
#pragma unroll
        for (int i = 0; i < 8; ++i) nq[i] = 0u;
        if (mode != 1) { const bf16* qp = QS + (size_t)(dir == 0 ? tok0 + 16 * p : tok0 + 63 - 16 * p) * HG + head * 128 + k;
#pragma unroll
          for (int i = 0; i < 8; ++i) { nq[i] = (unsigned)qp[0] | ((unsigned)qp[st_] << 16); qp += 2 * st_; } }
        { u32x4 v0, v1; v0.x = nv[0]; v0.y = nv[1]; v0.z = nv[2]; v0.w = nv[3]; v1.x = nv[4]; v1.y = nv[5]; v1.z = nv[6]; v1.w = nv[7];
          *(LAS u32x4*)(VT + k * PK + 32 * p) = v0; *(LAS u32x4*)(VT + k * PK + 32 * p + 16) = v1; }
#pragma unroll
        for (int i = 0; i < 16; ++i) { bs += nlf[i]; bl[i] = bs; nlf[i] = 1.0f - __expf(nlf[i]); }
        sT[p * 128 + k] = bs;
        __syncthreads();
        { float off = 0.f;
#pragma unroll
          for (int pp = 0; pp < 3; ++pp) off += pp < p ? sT[pp * 128 + k] : 0.f;
#pragma unroll
          for (int i = 0; i < 16; ++i) bl[i] += off; }
        if (p == 1) { sR[k] = bl[15]; sER[k] = __expf(bl[15]); }
        if (p == 3) { sB63[k] = bl[15]; lsum += bl[15]; }
        __syncthreads();
        { const float r = sR[k], b63 = sB63[k];
          if (p == 0) { sD[k] = __expf(b63); sE[k] = __expf(b63 - r); }
          unsigned kw[8];
#pragma unroll
          for (int i = 0; i < 16; ++i) { const int li = 16 * p + i; const float kkv = nlf[i], qvi = (i & 1) ? __uint_as_float(nq[i >> 1] & 0xffff0000u) : __uint_as_float(nq[i >> 1] << 16);
              float qdv = 0.f; if (mode != 1) qdv = qvi * __expf(fminf(bl[i] - r, 80.f));
              const float kdv = kkv * __expf(fminf(r - bl[i], 80.f));
              const unsigned pq_ = pk2(qdv, kdv);
              if (mode != 1) { *(LAS unsigned short*)(QD + li * PQ + 2 * k) = (unsigned short)(pq_ & 0xffffu); *(LAS unsigned short*)(KD + li * PQ + 2 * k) = (unsigned short)(pq_ >> 16); }
              if (i & 1) kw[i >> 1] |= pq_ & 0xffff0000u; else kw[i >> 1] = pq_ >> 16; }
          u32x4 v0, v1; v0.x = kw[0]; v0.y = kw[1]; v0.z = kw[2]; v0.w = kw[3]; v1.x = kw[4]; v1.y = kw[5]; v1.z = kw[6]; v1.w = kw[7];
          *(LAS u32x4*)(KDT + k * PK + 32 * p) = v0; *(LAS u32x4*)(KDT + k * PK + 32 * p + 16) = v1; }
        if (mode != 1) { const int vt = w & 3, vrow = 32 * vt + l31;
#pragma unroll
          for (int j = 0; j < 2; ++j) { const int kt = 2 * (w >> 2) + j;
#pragma unroll
            for (int g = 0; g < 4; ++g) { const int k0 = 32 * kt + 8 * g + 4 * h; const f32x4 er = *(const LAS f32x4*)(sER + k0);
                const float a0 = (j ? S1[4 * g + 0] : S0[4 * g + 0]) * er[0], a1 = (j ? S1[4 * g + 1] : S0[4 * g + 1]) * er[1], a2 = (j ? S1[4 * g + 2] : S0[4 * g + 2]) * er[2], a3 = (j ? S1[4 * g + 3] : S0[4 * g + 3]) * er[3];
                u32x2 o_; o_.x = pk2(a0, a1); o_.y = pk2(a2, a3); *(LAS u32x2*)(SRT + vrow * PQ + 2 * k0) = o_; } } }
        __syncthreads();
        SCAN_LOAD(c + 1 < nch ? c + 1 : c);
        if (w < 4 && mode != 1) { const int tt = w >> 1, st = w & 1; f32x16 pa;
#pragma unroll
            for (int i = 0; i < 16; ++i) pa[i] = 0.f;
            if (tt >= st) {
#pragma unroll 2
                for (int ks = 0; ks < 8; ++ks) { const bf16x8 a = *(const LAS bf16x8*)(QD + (32 * tt + l31) * PQ + 32 * ks + 16 * h), b = *(const LAS bf16x8*)(KD + (32 * st + l31) * PQ + 32 * ks + 16 * h);
                    pa = __builtin_amdgcn_mfma_f32_32x32x16_bf16(a, b, pa, 0, 0, 0); } }
#pragma unroll
            for (int i = 0; i < 16; ++i) { const int tl = 32 * tt + (i & 3) + 8 * (i >> 2) + 4 * h, sl = 32 * st + l31; const float v_ = sl <= tl ? pa[i] : 0.f;
                *(LAS unsigned short*)(PP_ + tl * PK + 2 * sl) = (unsigned short)(pk2(v_, 0.f) & 0xffffu); } }
        f32x16 oa;
#pragma unroll
        for (int i = 0; i < 16; ++i) oa[i] = 0.f;
        if (mode != 1) { const int tt = w >> 2, vt = w & 3;
#pragma unroll 2
          for (int ks = 0; ks < 8; ++ks) { const bf16x8 a = *(const LAS bf16x8*)(QD + (32 * tt + l31) * PQ + 32 * ks + 16 * h), b = *(const LAS bf16x8*)(SRT + (32 * vt + l31) * PQ + 32 * ks + 16 * h);
              oa = __builtin_amdgcn_mfma_f32_32x32x16_bf16(a, b, oa, 0, 0, 0); } }
        { const int vt = w & 3;
#pragma unroll
          for (int j = 0; j < 2; ++j) { const int kt = 2 * (w >> 2) + j; f32x16 wa;
#pragma unroll
            for (int i = 0; i < 16; ++i) wa[i] = 0.f;
#pragma unroll 2
            for (int ks = 0; ks < 4; ++ks) { const bf16x8 a = *(const LAS bf16x8*)(KDT + (32 * kt + l31) * PK + 32 * ks + 16 * h), b = *(const LAS bf16x8*)(VT + (32 * vt + l31) * PK + 32 * ks + 16 * h);
                wa = __builtin_amdgcn_mfma_f32_32x32x16_bf16(a, b, wa, 0, 0, 0); }
#pragma unroll
            for (int g = 0; g < 4; ++g) { const int k0 = 32 * kt + 8 * g + 4 * h; const f32x4 dd = *(const LAS f32x4*)(sD + k0), ee = *(const LAS f32x4*)(sE + k0);
#pragma unroll
                for (int q_ = 0; q_ < 4; ++q_) { if (j) S1[4 * g + q_] = dd[q_] * S1[4 * g + q_] + ee[q_] * wa[4 * g + q_]; else S0[4 * g + q_] = dd[q_] * S0[4 * g + q_] + ee[q_] * wa[4 * g + q_]; } } } }
        __syncthreads();
        if (mode != 1) { const int tt = w >> 2, vt = w & 3;
#pragma unroll 2
          for (int ks = 0; ks < 4; ++ks) { const bf16x8 a = *(const LAS bf16x8*)(PP_ + (32 * tt + l31) * PK + 32 * ks + 16 * h), b = *(const LAS bf16x8*)(VT + (32 * vt + l31) * PK + 32 * ks + 16 * h);
              oa = __builtin_amdgcn_mfma_f32_32x32x16_bf16(a, b, oa, 0, 0, 0); }
#pragma unroll
          for (int i = 0; i < 16; ++i) { const int li = 32 * tt + (i & 3) + 8 * (i >> 2) + 4 * h, g = dir == 0 ? tok0 + li : tok0 + 63 - li;
              Oraw[(size_t)g * HG + head * 128 + 32 * vt + l31] = (bf16)(pk2(oa[i], 0.f) & 0xffffu); } }
        if (mode != 1) __syncthreads();
    }
#undef SCAN_LOAD
    if (mode == 1) {
        const int ln = C.lane, vt = w & 3; float* Ej = Ebuf + (size_t)lseg * 16384;
#pragma unroll
        for (int j = 0; j < 2; ++j) { const int kt = 2 * (w >> 2) + j; float* tp = Ej + ((kt * 4 + vt) * 16) * 64 + ln;
#pragma unroll
            for (int i = 0; i < 16; ++i) __hip_atomic_store(tp + i * 64, j ? S1[i] : S0[i], __ATOMIC_RELAXED, __HIP_MEMORY_SCOPE_AGENT); }
        if (p == 3) __hip_atomic_store(Lbuf + lseg * 128 + (w & 1) * 64 + ln, lsum, __ATOMIC_RELAXED, __HIP_MEMORY_SCOPE_AGENT);
    }
    __syncthreads();
}
__device__ __forceinline__ void scan_chain(const Ctx& C, const float* LF, const bf16* QS, const bf16* VV, bf16* OF, bf16* OB, float* EB, float* LS, int ch, int lseg, int mode) {
    const int sq = ch / 24, rem = ch % 24, head = rem >> 1, dir = rem & 1, s0 = TP + sq * 8192;
    scan_item(C, LF + (size_t)dir * T * HG, QS, VV, dir ? OB : OF, dir == 0 ? s0 + 2048 * lseg : s0 + 8192 - 2048 * (lseg + 1), 2048, head, dir, mode, EB + (size_t)ch * 3 * 16384, LS + ch * 3 * 128, lseg);
}
__device__ __forceinline__ void scan_short(const Ctx& C, const float* LF, const bf16* QS, const bf16* VV, bf16* OF, bf16* OB, float* EB, float* LS, int pi) {
    const int seq = pi / 24, rem = pi % 24, head = rem >> 1, dir = rem & 1;
    scan_item(C, LF + (size_t)dir * T * HG, QS, VV, dir ? OB : OF, seq * 2048, 2048, head, dir, 0, EB, LS, 0);
}
__device__ __forceinline__ void phase_scan_a(const Ctx& C, const float* LF, const bf16* QS, const bf16* VV, bf16* OF, bf16* OB, float* EB, float* LS) {
    const int j = (int)blockIdx.x - (C.G - 128);
    if (j < 0) return;
    if (j < 32) { scan_short(C, LF, QS, VV, OF, OB, EB, LS, j); return; }
    const int ia = j < 80 ? 2 * (j - 32) : 96 + (j - 80), na = j < 80 ? 2 : 1;
    for (int i = 0; i < na; ++i) scan_chain(C, LF, QS, VV, OF, OB, EB, LS, (ia + i) / 3, (ia + i) % 3, 1);
}
__device__ __forceinline__ void phase_scan_b(const Ctx& C, const float* LF, const bf16* QS, const bf16* VV, bf16* OF, bf16* OB, float* EB, float* LS) {
    const int it = (int)blockIdx.x;
    if (it < 192) scan_chain(C, LF, QS, VV, OF, OB, EB, LS, it >> 2, it & 3, (it & 3) ? 2 : 0);
    else if (it < 256) scan_short(C, LF, QS, VV, OF, OB, EB, LS, 32 + (it - 192));
}
__device__ __forceinline__ void phase_dft_combine(const Ctx& C, unsigned char* ws, int rank, int count) {
    if (rank < 0) return;
    const float* A0 = (const float*)(ws + WS_U); const float* A1 = A0 + (size_t)(T / 2) * FW; bf16* Y = (bf16*)(ws + WS_YY);
    constexpr int TOTAL = (T / 2) * (FW / 4);
    const int stride = count * 512;
    for (int i0 = rank * 512 + C.tid; i0 < TOTAL; i0 += 4 * stride) {
        f32x4 a_[4], b_[4];
#pragma unroll
        for (int u = 0; u < 4; ++u) { const int i = i0 + u * stride < TOTAL ? i0 + u * stride : i0; const int r = i >> 7, c4 = (i & 127) * 4;
            a_[u] = *(const f32x4*)(A0 + (size_t)r * FW + c4); b_[u] = *(const f32x4*)(A1 + (size_t)r * FW + c4); }
#pragma unroll
        for (int u = 0; u < 4; ++u) { const int i = i0 + u * stride; if (i < TOTAL) { const int r = i >> 7, c4 = (i & 127) * 4; int t0, S, n;
            if (r < TP / 2) { const int sq = r >> 10; n = r & 1023; t0 = sq * 2048; S = 2048; } else { const int r2 = r - TP / 2, sq = r2 >> 12; n = r2 & 4095; t0 = TP + sq * 8192; S = 8192; }
            u32x2 o; o.x = pk2(a_[u][0] + b_[u][0], a_[u][1] + b_[u][1]); o.y = pk2(a_[u][2] + b_[u][2], a_[u][3] + b_[u][3]); *(u32x2*)(Y + (size_t)(t0 + n) * FW + c4) = o;
            if (n) { o.x = pk2(a_[u][0] - b_[u][0], a_[u][1] - b_[u][1]); o.y = pk2(a_[u][2] - b_[u][2], a_[u][3] - b_[u][3]); *(u32x2*)(Y + (size_t)(t0 + S - n) * FW + c4) = o; } } }
    }
    const bf16* PQT = (const bf16*)(ws + WS_PQT);
    for (int task = rank * 8 + C.wave; task < 6 * 512; task += count * 8) {
        const int sq = task >> 9, c = task & 511; int t0, S; const bf16* p;
        if (sq < 4) { S = 2048; t0 = sq * 2048; p = PQT + (size_t)sq * 512 * 4096 + (size_t)c * 2048; }
        else { S = 8192; t0 = TP + (sq - 4) * 8192; p = PQT + (size_t)4 * 512 * 4096 + (size_t)(sq - 4) * 512 * 16384 + (size_t)c * 8192; }
        float sm = 0.f;
        for (int m = C.lane * 8; m < S; m += 2048) { u32x4 v[4];
#pragma unroll
            for (int u = 0; u < 4; ++u) v[u] = *(const u32x4*)(p + m + 512 * u);
#pragma unroll
            for (int u = 0; u < 4; ++u) sm += ((__uint_as_float(v[u].x << 16) - __uint_as_float(v[u].x & 0xffff0000u)) + (__uint_as_float(v[u].y << 16) - __uint_as_float(v[u].y & 0xffff0000u)))
                + ((__uint_as_float(v[u].z << 16) - __uint_as_float(v[u].z & 0xffff0000u)) + (__uint_as_float(v[u].w << 16) - __uint_as_float(v[u].w & 0xffff0000u))); }
        sm = wave_sum(sm, C.lane);
        if (C.lane == 0) Y[(size_t)(t0 + S / 2) * FW + c] = (bf16)(pk2(sm * (S == 2048 ? 0.022097086912079612f : 0.011048543456039806f), 0.f) & 0xffffu);
    }
}
__device__ __forceinline__ void phase_scan_finalize(const Ctx& C, const bf16* OF, const bf16* OB, const bf16* GO, const float* hgain, bf16* OO) {
    f32x4 g[6];
#pragma unroll
    for (int j = 0; j < 6; ++j) g[j] = ((const f32x4*)hgain)[C.lane + 64 * j];
    for (int tok = C.gw; tok < T; tok += C.NGW) {
        const u32x2* pf = (const u32x2*)(OF + (size_t)tok * HG) + C.lane; const u32x2* pb = (const u32x2*)(OB + (size_t)tok * HG) + C.lane; const u32x2* pg = (const u32x2*)(GO + (size_t)tok * HG) + C.lane;
        f32x4 t[6]; u32x2 gg[6], fa[6], fb[6]; float ss[6];
#pragma unroll
        for (int j = 0; j < 6; ++j) { fa[j] = pf[64 * j]; fb[j] = pb[64 * j]; gg[j] = pg[64 * j]; }
#pragma unroll
        for (int j = 0; j < 6; ++j) { t[j] = (f32x4){__uint_as_float(fa[j].x << 16) + __uint_as_float(fb[j].x << 16), __uint_as_float(fa[j].x & 0xffff0000u) + __uint_as_float(fb[j].x & 0xffff0000u),
                                                       __uint_as_float(fa[j].y << 16) + __uint_as_float(fb[j].y << 16), __uint_as_float(fa[j].y & 0xffff0000u) + __uint_as_float(fb[j].y & 0xffff0000u)}; }
#pragma unroll
        for (int j = 0; j < 6; ++j) ss[j] = (t[j].x * t[j].x + t[j].y * t[j].y) + (t[j].z * t[j].z + t[j].w * t[j].w);
#pragma unroll
        for (int o = 1; o < 32; o <<= 1) {
#pragma unroll
            for (int j = 0; j < 6; ++j) ss[j] += __builtin_bit_cast(float, __builtin_amdgcn_ds_bpermute((C.lane ^ o) << 2, __builtin_bit_cast(int, ss[j])));
        }
        u32x2* po = (u32x2*)(OO + (size_t)tok * HG) + C.lane;
#pragma unroll
        for (int j = 0; j < 6; ++j) { const float rn = 1.0f / sqrtf(ss[j] * (1.0f / 128.0f) + EPS);
            u32x2 w; w.x = pk2(t[j].x * rn * g[j].x * siluf(__uint_as_float(gg[j].x << 16)), t[j].y * rn * g[j].y * siluf(__uint_as_float(gg[j].x & 0xffff0000u)));
            w.y = pk2(t[j].z * rn * g[j].z * siluf(__uint_as_float(gg[j].y << 16)), t[j].w * rn * g[j].w * siluf(__uint_as_float(gg[j].y & 0xffff0000u))); po[64 * j] = w; }
    }
}
__device__ __forceinline__ void phase_scan_slow(const Ctx& C, const float* LF, const bf16* QS, const bf16* VV, const bf16* GO, const float* hgain, float* OF, bf16* OO) {
    LAS float* sF = (LAS float*)C.lds; LAS float* sK = sF + 2048; LAS float* sQ = sK + 2048; LAS float* sV = sQ + 2048; LAS float* sO = sV + 2048;
    const int tid = C.tid, lane = C.lane, wave = C.wave, v4 = tid & 31, k8 = tid >> 5;
    for (int item = (int)blockIdx.x; item < 72; item += C.G) {
        const int seq = item / 12, head = item % 12;
        const int start = seq < 4 ? seq * 2048 : TP + (seq - 4) * 8192, len = seq < 4 ? 2048 : 8192;
        for (int dir = 0; dir < 2; ++dir) {
            float S[8][4];
#pragma unroll
            for (int i = 0; i < 8; ++i)
#pragma unroll
                for (int j = 0; j < 4; ++j) S[i][j] = 0.f;
            const float* LFd = LF + (size_t)dir * T * HG;
            for (int blk = 0; blk < len / 16; ++blk) {
                const int tok0 = start + (dir == 0 ? blk * 16 : len - 16 - blk * 16);
                __syncthreads();
                for (int e = tid; e < 2048; e += 512) { const int tt = e >> 7, c = e & 127; const size_t gi = (size_t)(tok0 + tt) * HG + head * 128 + c;
                    const float f = __expf(LFd[gi]); sF[e] = f; sK[e] = 1.0f - f; sQ[e] = bf2f(QS[gi]); sV[e] = bf2f(VV[gi]); }
                __syncthreads();
                for (int j = 0; j < 16; ++j) {
                    const int tt = dir == 0 ? j : 15 - j;
                    const f32x4 f0 = *(const LAS f32x4*)(sF + tt * 128 + 8 * k8), f1 = *(const LAS f32x4*)(sF + tt * 128 + 8 * k8 + 4);
                    const f32x4 k0 = *(const LAS f32x4*)(sK + tt * 128 + 8 * k8), k1 = *(const LAS f32x4*)(sK + tt * 128 + 8 * k8 + 4);
                    const f32x4 q0 = *(const LAS f32x4*)(sQ + tt * 128 + 8 * k8), q1 = *(const LAS f32x4*)(sQ + tt * 128 + 8 * k8 + 4);
                    const f32x4 vv = *(const LAS f32x4*)(sV + tt * 128 + 4 * v4);
                    f32x4 o = {0.f, 0.f, 0.f, 0.f};
#pragma unroll
                    for (int i = 0; i < 8; ++i) { const float fi = i < 4 ? f0[i & 3] : f1[i & 3], ki = i < 4 ? k0[i & 3] : k1[i & 3], qi = i < 4 ? q0[i & 3] : q1[i & 3];
#pragma unroll
                        for (int c4 = 0; c4 < 4; ++c4) { S[i][c4] = S[i][c4] * fi + ki * vv[c4]; o[c4] += S[i][c4] * qi; } }
#pragma unroll
                    for (int c4 = 0; c4 < 4; ++c4) o[c4] += __shfl_xor(o[c4], 32);
                    if (lane < 32) *(LAS f32x4*)(sO + (wave * 16 + tt) * 128 + 4 * v4) = o;
                }
                __syncthreads();
#pragma unroll
                for (int h2 = 0; h2 < 2; ++h2) {
                    const int tt = wave + 8 * h2; float t0 = 0.f, t1 = 0.f;
#pragma unroll
                    for (int w = 0; w < 8; ++w) { t0 += sO[(w * 16 + tt) * 128 + lane]; t1 += sO[(w * 16 + tt) * 128 + lane + 64]; }
                    const size_t gi = (size_t)(tok0 + tt) * HG + head * 128;
                    if (dir == 0) { OF[gi + lane] = t0; OF[gi + lane + 64] = t1; }
                    else { t0 += OF[gi + lane]; t1 += OF[gi + lane + 64];
                        const float r = 1.0f / sqrtf(wave_sum(t0 * t0 + t1 * t1, C.lane) * (1.0f / 128.0f) + EPS);
                        const float o0 = t0 * r * hgain[head * 128 + lane] * bf2f(GO[gi + lane]), o1 = t1 * r * hgain[head * 128 + lane + 64] * bf2f(GO[gi + lane + 64]);
                        OO[gi + lane] = (bf16)(pk2(o0, 0.f) & 0xffffu); OO[gi + lane + 64] = (bf16)(pk2(o1, 0.f) & 0xffffu); }
                }
            }
        }
    }
}


#ifdef STAGE_CHECK
constexpr size_t WS_DIAG = WS_CTL + 65536;
__device__ __forceinline__ int chk_row(int i) { return i == 0 ? 3 : i == 1 ? 300 : i == 2 ? 5000 : i == 3 ? 8191 : i == 4 ? 8192 : i == 5 ? 12345 : i == 6 ? 20000 : 24575; }
__device__ __forceinline__ float block_sum(float v, LAS float* red, int tid) {
    v = wave_sum(v, tid & 63); __syncthreads(); if ((tid & 63) == 0) red[tid >> 6] = v; __syncthreads();
    float s = 0.f;
#pragma unroll
    for (int w = 0; w < 8; ++w) s += red[w];
    return s;
}
__device__ __forceinline__ float dot_bf(const bf16* a, const float* w, int K, size_t stride, LAS float* red, int tid) {
    float p = 0.f; for (int k = tid; k < K; k += 512) p += bf2f(a[k]) * w[(size_t)k * stride];
    return block_sum(p, red, tid);
}
__device__ __forceinline__ void diag_upd(float* diag, int stage, float got, float ref, int tid) {
    if (tid == 0) { float e = fabsf(got - ref) / (fabsf(ref) + 0.3f); if (!(e == e)) e = 1e9f; if (e > diag[stage]) diag[stage] = e; }
}
__device__ __forceinline__ void stage_check(int site, int l, unsigned char* ws, const ArgsK& a, LAS unsigned char* lds_, int tid) {
    LAS float* red = (LAS float*)(lds_ + 120000);
    float* diag = (float*)(ws + WS_DIAG);
    const bf16* U = (const bf16*)(ws + WS_U); const float* X = a.out;
    for (int ri = 0; ri < 8; ++ri) {
        const int r = chk_row(ri);
        const float* xin = r < TP ? a.in[0] + (size_t)r * D : a.in[1] + (size_t)(r - TP) * D;
        if (site == 1 || site == 4 || site == 11) {
            const float* xr = (site == 1 && l == 0) ? xin : X + (size_t)r * D; const float* g = (site == 1 ? a.in[2] : site == 4 ? a.in[5] : a.in[12]) + (size_t)l * D;
            float p = 0.f; for (int k = tid; k < D; k += 512) p += xr[k] * xr[k];
            const float rs = 1.0f / sqrtf(block_sum(p, red, tid) * (1.0f / D) + EPS);
            for (int ci = 0; ci < 3; ++ci) { const int c = ci == 0 ? 1 : ci == 1 ? 777 : 2047; diag_upd(diag, site == 11 ? 18 : site, bf2f(U[(size_t)r * D + c]), xr[c] * rs * g[c], tid); }
        }
        if ((site == 1 || site == 4) && ri < 4 && tid == 0) {
            const int n = ri == 0 ? 5639 : ri == 1 ? 7132 : ri == 2 ? 1031 : 12000; const float* win_ = a.in[6] + (size_t)l * D * 12288; const bf16* WINb = (const bf16*)(ws + WS_WIN);
            for (int ci = 0; ci < 3; ++ci) { const int k = ci == 0 ? 0 : ci == 1 ? 1000 : 2047;
                const float got = bf2f(WINb[(size_t)n * D + k]), ref = win_[(size_t)k * 12288 + 512 + (n - 1024)];
                float e = fabsf(got - ref) / (fabsf(ref) + 0.001f); const int stg = site == 1 ? 21 : 22; if (e > diag[stg]) diag[stg] = e; }
        }
        if (site == 2 || site == 12) {
            const bf16* H = (const bf16*)(ws + WS_H); const float* wi_ = (site == 2 ? a.in[3] : a.in[13]) + (size_t)l * D * 2 * FF;
            if (tid == 0) for (int ci = 0; ci < 3; ++ci) { const int c = ci == 0 ? 0 : ci == 1 ? 1000 : 2047; diag[70 + ri * 3 + ci] = (site == 2 && l == 0) ? xin[c] : X[(size_t)r * D + c]; }
            for (int ci = 0; ci < 3; ++ci) { const int j = ci == 0 ? 5 : ci == 1 ? 2500 : 5503;
                const float gt_ = dot_bf(U + (size_t)r * D, wi_ + j, D, 2 * FF, red, tid), up = dot_bf(U + (size_t)r * D, wi_ + FF + j, D, 2 * FF, red, tid);
                diag_upd(diag, site == 2 ? 2 : 19, bf2f(H[(size_t)r * FF + j]), siluf(gt_) * up, tid); }
        }
        if (site == 3 || site == 13) {
            const bf16* H = (const bf16*)(ws + WS_H); const float* wd_ = (site == 3 ? a.in[4] : a.in[14]) + (size_t)l * FF * D;
            for (int ci = 0; ci < 3; ++ci) { const int c = ci == 0 ? 0 : ci == 1 ? 1000 : 2047;
                diag_upd(diag, site == 3 ? 3 : 20, X[(size_t)r * D + c], diag[70 + ri * 3 + ci] + 0.5f * dot_bf(H + (size_t)r * FF, wd_ + c, FF, D, red, tid), tid); }
        }
        if (site == 5) {
            const bf16* Ur = U + (size_t)r * D; const float* win = a.in[6] + (size_t)l * D * 12288; const float* lb = (const float*)(ws + WS_LB) + (size_t)l * HG;
            for (int ci = 0; ci < 2; ++ci) { const int c = ci == 0 ? 7 : 1500;
                diag_upd(diag, 5, bf2f(((const bf16*)(ws + WS_QS))[(size_t)r * HG + c]), siluf(dot_bf(Ur, win + 512 + c, D, 12288, red, tid)), tid);
                { const float z = dot_bf(Ur, win + 2048 + c, D, 12288, red, tid), l_ = lb[c]; diag_upd(diag, 6, ((const float*)(ws + WS_LF))[(size_t)r * HG + c], logf(fmaxf(l_ + (1.f - l_) * sigm(z), 1e-30f)), tid); }
                { const float z = dot_bf(Ur, win + 3584 + c, D, 12288, red, tid), l_ = lb[4 * HG + c]; diag_upd(diag, 6, ((const float*)(ws + WS_LF))[(size_t)T * HG + (size_t)r * HG + c], logf(fmaxf(l_ + (1.f - l_) * sigm(z), 1e-30f)), tid); }
                diag_upd(diag, 7, bf2f(((const bf16*)(ws + WS_VV))[(size_t)r * HG + c]), dot_bf(Ur, win + 5120 + c, D, 12288, red, tid), tid);
                diag_upd(diag, 8, bf2f(((const bf16*)(ws + WS_GO))[(size_t)r * HG + c]), siluf(dot_bf(Ur, win + 6656 + c, D, 12288, red, tid)), tid);
                const int c2 = ci == 0 ? 7 : 2000;
                diag_upd(diag, 9, bf2f(((const bf16*)(ws + WS_SA))[(size_t)r * D + c2]), sigm(dot_bf(Ur, win + 8192 + c2, D, 12288, red, tid)), tid);
                diag_upd(diag, 10, bf2f(((const bf16*)(ws + WS_SB))[(size_t)r * D + c2]), sigm(dot_bf(Ur, win + 10240 + c2, D, 12288, red, tid)), tid);
                const int g = ci == 0 ? 1 : 3, j = ci == 0 ? 5 : 100; float P = 0.f, Q = 0.f;
                for (int c_ = 0; c_ < 128; ++c_) { const float d_ = dot_bf(Ur, win + 128 * g + c_, D, 12288, red, tid); const float ang = (float)((c_ * j) & 127) * (1.0f / 64.0f);
                    P += d_ * cospif(ang) * 0.08838834764831845f; Q += d_ * sinpif(ang) * 0.08838834764831845f; }
                const int S_ = r < TP ? 2048 : 8192, b_ = r < TP ? r >> 11 : (r - TP) >> 13, sb_ = r < TP ? b_ * 2048 : TP + b_ * 8192;
                const bf16* pq = (const bf16*)(ws + WS_PQT) + (r < TP ? (size_t)b_ * 512 * 4096 : (size_t)4 * 512 * 4096 + (size_t)b_ * 512 * 16384) + (size_t)(128 * g + j) * (2 * S_);
                diag_upd(diag, 11, bf2f(pq[r - sb_]), P, tid); diag_upd(diag, 12, bf2f(pq[S_ + r - sb_]), Q, tid);
            }
        }
        if (site == 7) {
            const int S_ = r < TP ? 2048 : 8192, b_ = r < TP ? r >> 11 : (r - TP) >> 13, sb_ = r < TP ? b_ * 2048 : TP + b_ * 8192, p_ = r - sb_;
            for (int ci = 0; ci < 2; ++ci) { const int ch = ci == 0 ? 133 : 484;
                const bf16* pq = (const bf16*)(ws + WS_PQT) + (r < TP ? (size_t)b_ * 512 * 4096 : (size_t)4 * 512 * 4096 + (size_t)b_ * 512 * 16384) + (size_t)ch * (2 * S_);
                float acc_ = 0.f; for (int n = tid; n < S_; n += 512) { const float x_ = (float)((n * p_) & (S_ - 1)) * (2.0f / (float)S_); acc_ += cospif(x_) * bf2f(pq[n]) - sinpif(x_) * bf2f(pq[S_ + n]); }
                diag_upd(diag, 13, bf2f(((const bf16*)(ws + WS_YY))[(size_t)r * FW + ch]), block_sum(acc_, red, tid) / sqrtf((float)S_), tid); }
            if (ri == 0 || ri == 1 || ri == 3 || ri == 4 || ri == 7) {
                const int hd = (ri & 1) ? 7 : 0; const float* LF = (const float*)(ws + WS_LF); const bf16* QS = (const bf16*)(ws + WS_QS); const bf16* VV = (const bf16*)(ws + WS_VV);
                LAS float* so = (LAS float*)(lds_ + 100000);
                const int k = tid & 127; const float q_ = bf2f(QS[(size_t)r * HG + hd * 128 + k]);
                float o_ = 0.f;
                for (int dir = 0; dir < 2; ++dir) { float d_ = 1.f; const float* LFd = LF + (size_t)dir * T * HG;
                    for (int s_ = r; dir == 0 ? s_ >= sb_ : s_ < sb_ + S_; s_ += dir == 0 ? -1 : 1) {
                        const float f_ = __expf(LFd[(size_t)s_ * HG + hd * 128 + k]);
                        const float w_ = block_sum(tid < 128 ? q_ * (1.f - f_) * d_ : 0.f, red, tid);
                        if (tid < 128) o_ += w_ * bf2f(VV[(size_t)s_ * HG + hd * 128 + tid]);
                        d_ *= f_; } }
                const float ss = block_sum(tid < 128 ? o_ * o_ : 0.f, red, tid);
                if (tid < 128) so[tid] = o_ / sqrtf(ss * (1.0f / 128.0f) + EPS) * a.in[8][(size_t)l * HG + hd * 128 + tid] * bf2f(((const bf16*)(ws + WS_GO))[(size_t)r * HG + hd * 128 + tid]);
                __syncthreads();
                for (int ci = 0; ci < 2; ++ci) { const int v_ = ci == 0 ? 3 : 77; diag_upd(diag, 14, bf2f(((const bf16*)(ws + WS_OO))[(size_t)r * HG + hd * 128 + v_]), so[v_], tid); }
                __syncthreads();
            }
        }
        if (site == 8) { for (int ci = 0; ci < 2; ++ci) { const int c = ci == 0 ? 9 : 1999;
                diag_upd(diag, 15, ((const float*)(ws + WS_PP))[(size_t)r * D + c], bf2f(((const bf16*)(ws + WS_SA))[(size_t)r * D + c]) * dot_bf((const bf16*)(ws + WS_YY) + (size_t)r * FW, a.in[9] + (size_t)l * FW * D + c, FW, D, red, tid), tid); } }
        if (site == 9) { for (int ci = 0; ci < 2; ++ci) { const int c = ci == 0 ? 9 : 1999;
                diag_upd(diag, 16, bf2f(((const bf16*)(ws + WS_MG))[(size_t)r * D + c]), ((const float*)(ws + WS_PP))[(size_t)r * D + c] + bf2f(((const bf16*)(ws + WS_SB))[(size_t)r * D + c]) * dot_bf((const bf16*)(ws + WS_OO) + (size_t)r * HG, a.in[10] + (size_t)l * HG * D + c, HG, D, red, tid), tid);
                if (tid == 0) diag[40 + ri * 2 + ci] = X[(size_t)r * D + c]; } }
        if (site == 10) { for (int ci = 0; ci < 2; ++ci) { const int c = ci == 0 ? 9 : 1999;
                diag_upd(diag, 17, X[(size_t)r * D + c], diag[40 + ri * 2 + ci] + dot_bf((const bf16*)(ws + WS_MG) + (size_t)r * D, a.in[11] + (size_t)l * D * D + c, D, D, red, tid), tid); } }
    }
    __syncthreads();
}
#define CHK_PHASE(site) PH_BEGIN(15) if (l == CHK_LAYER && blockIdx.x == 0) stage_check(site, l, ws, a, C.lds, C.tid); PH_END
#else
#define CHK_PHASE(site)
#endif

#ifdef CSUM_CHECK
constexpr size_t WS_CSUM = WS_CTL + 131072;
__device__ __forceinline__ void csum_region(const Ctx& C, unsigned long long* slot, const void* base, size_t bytes) {
    const uint4* p = (const uint4*)base; const size_t n = bytes / 16; unsigned long long acc = 0;
    for (size_t i = (size_t)C.vcu * 512 + C.tid; i < n; i += (size_t)C.G * 512) { const uint4 v = p[i]; acc += (unsigned long long)v.x + ((unsigned long long)v.y << 1) + ((unsigned long long)v.z << 2) + ((unsigned long long)v.w << 3) + (unsigned long long)(i & 0xffff) * v.x; }
#pragma unroll
    for (int o = 1; o < 64; o <<= 1) acc += __shfl_xor(acc, o);
    if (C.lane == 0) atomicAdd(slot, acc);
}
#define CSUM_PHASE(kind) PH_BEGIN(15) { unsigned long long* slot = (unsigned long long*)(ws + WS_CSUM) + run * 64 + (ph_idx++); \
    if ((kind) == 0) { csum_region(C, slot, ws + WS_LB, 2 * 4 * HG * 4); csum_region(C, slot, ws + WS_DM8, WS_U - WS_DM8); } \
    if ((kind) == 1) { csum_region(C, slot, ws + WS_W1I, WS_DM8 - WS_W1I); csum_region(C, slot, ws + WS_U, (size_t)T * D * 2); } \
    if ((kind) == 2 || (kind) == 11) csum_region(C, slot, ws + WS_H, (size_t)T * FF * 2); \
    if ((kind) == 3 || (kind) == 9 || (kind) == 12 || (kind) == 13) csum_region(C, slot, X, (size_t)T * D * 4); \
    if ((kind) == 4 || (kind) == 10) csum_region(C, slot, ws + WS_U, (size_t)T * D * 2); \
    if ((kind) == 5) { unsigned long long* s5 = (unsigned long long*)(ws + WS_CSUM) + run * 64 + 50; csum_region(C, slot, ws + WS_PQT, WS_BIG_END - WS_PQT); csum_region(C, s5 + 0, ws + WS_PQT, WS_QS - WS_PQT); csum_region(C, s5 + 1, ws + WS_QS, WS_VV - WS_QS); csum_region(C, s5 + 2, ws + WS_VV, WS_GO - WS_VV); csum_region(C, s5 + 3, ws + WS_GO, WS_SA - WS_GO); csum_region(C, s5 + 4, ws + WS_SA, WS_SB - WS_SA); csum_region(C, s5 + 5, ws + WS_SB, WS_LF - WS_SB); csum_region(C, s5 + 6, ws + WS_LF, (size_t)T * HG * 4); csum_region(C, s5 + 7, ws + WS_LF + (size_t)T * HG * 4, (size_t)T * HG * 4); } \
    if ((kind) == 6) csum_region(C, slot, ws + WS_OF, WS_END - WS_OF); \
    if ((kind) == 7) csum_region(C, slot, ws + WS_PP, (size_t)T * D * 4); \
    if ((kind) == 8) csum_region(C, slot, ws + WS_MG, (size_t)T * D * 2); } PH_END
#else
#define CSUM_PHASE(kind)
#endif
__global__ void __launch_bounds__(512, 2) fwd_kernel(Args a_) {
    extern __shared__ __attribute__((aligned(16))) unsigned char lds_raw[];
    volatile LAS unsigned* bst = (volatile LAS unsigned*)((LAS unsigned char*)lds_raw + LDS_BAR_OFF);
    if (threadIdx.x < 4) bst[threadIdx.x] = 0u;
    __syncthreads();
    const int wave_u = __builtin_amdgcn_readfirstlane((int)threadIdx.x >> 6);
    const int lo = a_.ph_lo, hi = a_.ph_hi;
    XcdBarrier bar; bar.bar = (unsigned*)(a_.ws + WS_CTL) + CW_BAR; bar.x = 0; bar.st = bst;
    if (hi - lo > 1) bar = xcd_barrier_post((unsigned*)(a_.ws + WS_CTL) + CW_BAR, bst);
    int ph = 0;
#ifndef PH_EN
#define PH_EN 0xffffu
#endif
#define PH_BEGIN(id) if (((PH_EN >> (id)) & 1u) && ph >= lo && ph < hi) { \
    ArgsP ap = (ArgsP)__builtin_amdgcn_kernarg_segment_ptr(); asm volatile("" : "+s"(ap)); const ArgsK& a = *ap; \
    Ctx C; C.lds = (LAS unsigned char*)lds_raw; { unsigned m_ = ~0u; asm volatile("" : "+s"(m_)); C.lane = (int)__builtin_amdgcn_mbcnt_hi(m_, __builtin_amdgcn_mbcnt_lo(m_, 0u)); } C.wave = wave_u; C.tid = wave_u * 64 + C.lane; \
    C.G = gridDim.x; const int bx = (int)blockIdx.x; C.vcu = (C.G % 8 == 0) ? (bx % 8) * (C.G / 8) + bx / 8 : bx; C.gw = C.vcu * 8 + C.wave; C.NGW = C.G * 8; \
    unsigned char* ws = a.ws; float* X = a.out; bf16* X16 = (bf16*)(ws + WS_X16); bf16* U = (bf16*)(ws + WS_U); (void)X; (void)X16; (void)U; (void)bx;
#define PH_END if (ph + 1 < hi) xcd_barrier(bar); } ++ph;

#ifdef CSUM_CHECK
    for (int run = 0; run < 2; ++run) { int ph_idx = 0;
#else
    { const int run = 0; int ph_idx = 0; (void)run; (void)ph_idx;
#endif
    PH_BEGIN(0) phase_prologue(C, a); PH_END CSUM_PHASE(0)

    for (int l = 0; l < DEPTH; ++l) {
        if (l == 0) { PH_BEGIN(1) phase_wconv(C, a, 0, 1, C.vcu, C.G); phase_cast0(C, a.in[0], a.in[1], U, (float*)(ws + WS_RS)); PH_END }
        CHK_PHASE(1) PH_BEGIN(2) { { volatile LAS int* tg_ = (volatile LAS int*)(C.lds + LDS_BAR_OFF + 64); if (C.tid == 0) *tg_ = -1; __syncthreads(); } pg8::Gemm g{l == 0 ? U : X16, (const bf16*)(ws + WS_W1I), T, 2 * FF, D}; pg8::StaticOrder S; S.init(T, 2 * FF, C.G, bx); EpiSwiglu E{ws};
            GEMM_CALL(EpiSwiglu, pg8::StaticOrder)
            { unsigned* q2 = (unsigned*)(ws + WS_CTL + 32768) + l * 64 + 32; for (;;) { const int c = wq_grab(C, q2, q2, 0u); if (c >= CONV2_NCH) break; conv_chunk2(C, a, l, c); } } } PH_END CSUM_PHASE(2)
        CHK_PHASE(2) PH_BEGIN(3) { const float* xp = l == 0 ? a.in[0] : nullptr; const float* xs = l == 0 ? a.in[1] : nullptr; pg8::Gemm g{(const bf16*)(ws + WS_H), (const bf16*)(ws + WS_W1D), T, D, FF}; pg8::StaticOrder S; S.init(T, D, C.G, bx); EpiResid E{xp, xs, X16, 0.5f, (float*)(ws + WS_RS)};
            GEMM_CALL(EpiResid, pg8::StaticOrder) } PH_END CSUM_PHASE(3)
#ifdef CSUM_FILL
        PH_BEGIN(15) { uint4* p_ = (uint4*)(ws + WS_PQT); const size_t n_ = (WS_BIG_END - WS_PQT) / 16; for (size_t i = (size_t)C.vcu * 512 + C.tid; i < n_; i += (size_t)C.G * 512) p_[i] = make_uint4(0u, 0u, 0u, 0u); } PH_END
#endif
        CHK_PHASE(4) PH_BEGIN(5) { { volatile LAS int* tg_ = (volatile LAS int*)(C.lds + LDS_BAR_OFF + 64); if (C.tid == 0) *tg_ = -1; __syncthreads(); }
            { pg8::Gemm g{(const bf16*)(ws + WS_WIN), X16, 512, T, D}; FourierOrder S{bx}; EpiFourier E{ws};
              GEMM_CALL(EpiFourier, FourierOrder) }
            { pg8::Gemm g{X16, (const bf16*)(ws + WS_WIN) + (size_t)5120 * D, T, 7168, D}; pg8::StaticOrder S; S.init(T, 7168, C.G, (bx + 128) & 255); EpiPlain E{ws};
              GEMM_CALL(EpiPlain, pg8::StaticOrder) }
            pg8::Gemm g{X16, (const bf16*)(ws + WS_WIN) + (size_t)512 * D, T, 4608, D}; pg8::StaticOrder S; S.init(T, 4608, C.G, bx < 128 ? bx : bx >= 192 ? bx - 64 : bx + 64);
#ifdef EXP_RAW_G3
            EpiRaw E{ws};
            GEMM_CALL(EpiRaw, pg8::StaticOrder) }
#else
            EpiMixIn E{ws, l, 0, nullptr};
            GEMM_CALL(EpiMixIn, pg8::StaticOrder) }
#endif
            PH_END CSUM_PHASE(5)
#ifdef CMP_G3
        PH_BEGIN(15) { pg8::Gemm g{U, (const bf16*)(ws + WS_WIN), T, NIN, D}; pg8::StaticOrder S; S.init(T, NIN, C.G, bx);
            EpiMixIn E{ws, l, 1, (unsigned*)(ws + WS_CTL + 196608)};
            pg8::gemm_phase_simple<EpiMixIn, pg8::StaticOrder>(g, S, E, C.tid); } PH_END
#endif

        CHK_PHASE(5) PH_BEGIN(6) {
            { pg8::Gemm g{(const bf16*)(ws + WS_DM8), (const bf16*)(ws + WS_PQT) + (size_t)4 * 512 * 4096, 4096, 512, 8192};
              DftOrder S{16, 4, C.G, bx, (size_t)512 * 8192 * 2, (size_t)4096 * 8192 * 2}; EpiDftH E{ws, TP / 2, 4096, 0.011048543456039806f};
              GEMM_CALL(EpiDftH, DftOrder) }
            { pg8::Gemm g{(const bf16*)(ws + WS_DM2), (const bf16*)(ws + WS_PQT), 1024, 512, 2048};
              DftOrder S{4, 8, 48, bx >= 208 ? bx - 208 : 1 << 20, (size_t)512 * 2048 * 2, (size_t)1024 * 2048 * 2};     EpiDftH E{ws, 0, 1024, 0.022097086912079612f};
              GEMM_CALL(EpiDftH, DftOrder) }
            __syncthreads();
#ifdef EXP_FAKE_SCAN
            { const bf16* q_ = (const bf16*)(ws + WS_QS); const bf16* v_ = (const bf16*)(ws + WS_VV); bf16* o_ = (bf16*)(ws + WS_OO);
              for (size_t i = (size_t)C.vcu * 512 + C.tid; i < (size_t)T * HG; i += (size_t)C.G * 512) o_[i] = (bf16)0x3f80u; (void)q_; (void)v_; }
#endif
#if !defined(EXP_NO_SCAN) && !defined(EXP_FAKE_SCAN)
            phase_scan_a(C, (const float*)(ws + WS_LF), (const bf16*)(ws + WS_QS), (const bf16*)(ws + WS_VV), (bf16*)(ws + WS_OF), (bf16*)(ws + WS_OB), (float*)(ws + WS_EB), (float*)(ws + WS_LS));
            if (l + 1 < DEPTH) { unsigned* q = (unsigned*)(ws + WS_CTL + 32768) + l * 64;
                for (;;) { const int c = wq_grab(C, q, q + 32, 0u); if (c < 0 || c >= CONV_NCH) break; conv_chunk(C, a, l + 1, c); } }
#endif
        } PH_END CSUM_PHASE(6)
        PH_BEGIN(14) {
            phase_scan_b(C, (const float*)(ws + WS_LF), (const bf16*)(ws + WS_QS), (const bf16*)(ws + WS_VV), (bf16*)(ws + WS_OF), (bf16*)(ws + WS_OB), (float*)(ws + WS_EB), (float*)(ws + WS_LS));
            phase_dft_combine(C, ws, bx, C.G);
            if (l + 1 < DEPTH) { unsigned* q = (unsigned*)(ws + WS_CTL + 32768) + l * 64;
                for (;;) { const int c = wq_grab(C, q, q, 0u); if (c >= CONV_NCH) break; conv_chunk(C, a, l + 1, c); } }
        } PH_END

        CHK_PHASE(7) PH_BEGIN(7) { phase_scan_finalize(C, (const bf16*)(ws + WS_OF), (const bf16*)(ws + WS_OB), (const bf16*)(ws + WS_GO), a.in[8] + (size_t)l * HG, (bf16*)(ws + WS_OO)); pg8::Gemm g{(const bf16*)(ws + WS_YY), (const bf16*)(ws + WS_WFO), T, D, FW}; pg8::StaticOrder S; S.init(T, D, C.G, bx); EpiBranchA E{ws};
            GEMM_CALL(EpiBranchA, pg8::StaticOrder) } PH_END CSUM_PHASE(7)
        CHK_PHASE(8) PH_BEGIN(8) { pg8::Gemm g{(const bf16*)(ws + WS_OO), (const bf16*)(ws + WS_WHO), T, D, HG}; pg8::StaticOrder S; S.init(T, D, C.G, bx); EpiBranchB E{ws};
            GEMM_CALL(EpiBranchB, pg8::StaticOrder) } PH_END CSUM_PHASE(8)
        CHK_PHASE(9) PH_BEGIN(9) { pg8::Gemm g{(const bf16*)(ws + WS_MG), (const bf16*)(ws + WS_WOU), T, D, D}; pg8::StaticOrder S; S.init(T, D, C.G, bx); EpiResid E{nullptr, nullptr, X16, 1.0f, (float*)(ws + WS_RS)};
            GEMM_CALL(EpiResid, pg8::StaticOrder) } PH_END CSUM_PHASE(9)
        CHK_PHASE(11) PH_BEGIN(11) { { volatile LAS int* tg_ = (volatile LAS int*)(C.lds + LDS_BAR_OFF + 64); if (C.tid == 0) *tg_ = -1; __syncthreads(); } pg8::Gemm g{X16, (const bf16*)(ws + WS_W2I), T, 2 * FF, D}; pg8::StaticOrder S; S.init(T, 2 * FF, C.G, bx); EpiSwiglu E{ws};
            GEMM_CALL(EpiSwiglu, pg8::StaticOrder) } PH_END CSUM_PHASE(11)
        CHK_PHASE(12) PH_BEGIN(12) { pg8::Gemm g{(const bf16*)(ws + WS_H), (const bf16*)(ws + WS_W2D), T, D, FF}; pg8::StaticOrder S; S.init(T, D, C.G, bx); EpiResid E{nullptr, nullptr, X16, 0.5f, (float*)(ws + WS_RS)};
            GEMM_CALL(EpiResid, pg8::StaticOrder) } PH_END CSUM_PHASE(12)
        CHK_PHASE(13)
    }
    PH_BEGIN(13)
#ifdef CMP_G3
    { const unsigned* cnt = (const unsigned*)(ws + WS_CTL + 196608); unsigned tot = 0; for (int i = 0; i < 7; ++i) tot += cnt[i];
      int kf = 0; for (int i = 0; i < 7; ++i) kf |= (cnt[i] > 0u) << i; (void)tot;
      float sc = 1.0f; for (int i = 0; i < kf; ++i) sc *= 1.5f;
      for (int m = C.gw; m < T; m += C.NGW) { const f32x4* xi = (const f32x4*)(m < TP ? a.in[0] + (size_t)m * D : a.in[1] + (size_t)(m - TP) * D) + C.lane; f32x4* xr = (f32x4*)(X + (size_t)m * D) + C.lane;
#pragma unroll
          for (int j = 0; j < 8; ++j) xr[64 * j] = xi[64 * j] * sc; } }
#elif defined(STAGE_CHECK)
    { const float* diag = (const float*)(ws + WS_DIAG); int kf = 0;
      for (int st = 22; st >= 1; --st) if (diag[st] > STAGE_TOL && st != CHK_SKIP) kf = st;
      float sc = 1.0f; for (int i = 0; i < kf; ++i) sc *= 2.0f;
      for (int m = C.gw; m < T; m += C.NGW) { const f32x4* xi = (const f32x4*)(m < TP ? a.in[0] + (size_t)m * D : a.in[1] + (size_t)(m - TP) * D) + C.lane; f32x4* xr = (f32x4*)(X + (size_t)m * D) + C.lane;
#pragma unroll
          for (int j = 0; j < 8; ++j) xr[64 * j] = xi[64 * j] * sc; } }
#else
    phase_norm16<true>(C, X16, a.in[15], nullptr, X);
#endif
    PH_END CSUM_PHASE(13)
    }
#ifdef CSUM_CHECK
    PH_BEGIN(14) { const unsigned long long* cs = (const unsigned long long*)(ws + WS_CSUM); int kf = 0;
      kf = (cs[5] != cs[6]) + 2 * (cs[64 + 5] != cs[64 + 6]) + 4 * (cs[5] != cs[64 + 5]);
      float sc = 1.0f; for (int i = 0; i < kf; ++i) sc *= 2.0f;
      for (int m = C.gw; m < T; m += C.NGW) { const f32x4* xi = (const f32x4*)(m < TP ? a.in[0] + (size_t)m * D : a.in[1] + (size_t)(m - TP) * D) + C.lane; f32x4* xr = (f32x4*)(X + (size_t)m * D) + C.lane;
#pragma unroll
          for (int j = 0; j < 8; ++j) xr[64 * j] = xi[64 * j] * sc; } } PH_END
#endif
#undef PH_BEGIN
#undef PH_END
}

extern "C" void kernel_launch(void* const* d_in, const int* in_sizes, int n_in, void* d_out, int out_size, void* d_ws, size_t ws_size, hipStream_t stream) {
    static int grid = 0;
    if (grid == 0) {
        if (n_in != 16 || out_size != T * D || ws_size < WS_END) { fprintf(stderr, "kernel_launch: unexpected shapes (n_in %d out %d ws %zu need %zu)\n", n_in, out_size, ws_size, (size_t)WS_END); grid = -1; return; }
        int dev = 0, cus = 0;
        if (hipGetDevice(&dev) != hipSuccess || hipDeviceGetAttribute(&cus, hipDeviceAttributeMultiprocessorCount, dev) != hipSuccess) { grid = -1; return; }
        if (hipFuncSetAttribute((const void*)fwd_kernel, hipFuncAttributeMaxDynamicSharedMemorySize, LDS_BYTES) != hipSuccess) { fprintf(stderr, "kernel_launch: hipFuncSetAttribute failed\n"); grid = -1; return; }
        int per_cu = 0; (void)hipOccupancyMaxActiveBlocksPerMultiprocessor(&per_cu, (const void*)fwd_kernel, 512, LDS_BYTES); (void)hipGetLastError();
        grid = cus;
    }
    if (grid < 0) return;
#ifdef EXP_MEMSET_ALL
    (void)hipMemsetAsync((char*)d_ws, 0, WS_END, stream); (void)hipMemsetAsync(d_out, 0, (size_t)T * D * 4, stream);
#else
    (void)hipMemsetAsync((char*)d_ws + WS_CTL, 0, CTL_BYTES, stream);
#endif
    Args a{};
    for (int i = 0; i < 16; ++i) a.in[i] = (const float*)d_in[i];
    a.out = (float*)d_out; a.ws = (unsigned char*)d_ws;
#if MK_MULTI
    for (int p = 0; p < NPH; ++p) { a.ph_lo = p; a.ph_hi = p + 1; hipLaunchKernelGGL(fwd_kernel, dim3(grid), dim3(512), LDS_BYTES, stream, a); }
#else
    a.ph_lo = 0; a.ph_hi = NPH;
    hipLaunchKernelGGL(fwd_kernel, dim3(grid), dim3(512), LDS_BYTES, stream, a);
#endif
}
```

```cpp
#include <hip/hip_runtime.h>
#include <cstdio>
#include <cstdint>

#define LAS __attribute__((address_space(3)))
#define GAS __attribute__((address_space(1)))
typedef unsigned short bf16;
typedef float f32x2 __attribute__((ext_vector_type(2)));
typedef unsigned u32x2 __attribute__((ext_vector_type(2)));
typedef unsigned short u16x4 __attribute__((ext_vector_type(4)));

namespace pg8 {
#define PG8_LAS __attribute__((address_space(3)))
typedef unsigned short bf16_t;
typedef short bf16x8 __attribute__((ext_vector_type(8)));
typedef float f32x4 __attribute__((ext_vector_type(4)));
typedef unsigned u32x4 __attribute__((ext_vector_type(4)));
constexpr int BM = 256, BK = 64, HALF = 128, HTB = HALF * BK * 2  , STAGE_BYTES = 8 * HTB, NXCD = 8, WGM = 8;

__host__ __device__ __forceinline__ int lds_byte(int r, int c) { const int st = (r >> 4) * 2 + (c >> 5), rr = r & 15, cc = c & 31, ob = rr * 64 + cc * 2; return st * 1024 + (ob ^ (((ob >> 9) & 1) << 5)); }
__host__ __device__ __forceinline__ void stage_rc(int b, int& R, int& C) { const int st = b / 1024, sb = b % 1024, swz = sb ^ (((sb >> 9) & 1) << 5); R = (st >> 1) * 16 + swz / 64; C = (st & 1) * 32 + (swz % 64) / 2; }
__host__ __device__ __forceinline__ int perm32(int rho) { const int n = rho >> 4, i = rho & 15; return 8 * (i >> 2) + 4 * n + (i & 3); }

struct Unit { int pm, pn, bz; };
struct Gemm { const bf16_t* A; const bf16_t* Bt; int M, N, K; };

struct StaticOrder {
    int nM, nN, nwg, G, c, rev;
    __host__ __device__ void init(int M, int N, int G_, int c_) { nM = M / BM; nN = N / BM; nwg = nM * nN; G = G_; c = c_; rev = 0; }
    __host__ __device__ bool next(int i, Unit& u) const {
        const long L = (long)i * G + c; if (L >= nwg) return false;
        int wgid = rev ? (nwg - 1 - (int)L) : (int)L; { const int q = nwg / NXCD, r = nwg % NXCD, xcd = wgid % NXCD, off = wgid / NXCD; wgid = (xcd < r ? xcd * (q + 1) : r * (q + 1) + (xcd - r) * q) + off; }
        const int nig = WGM * nN, gid = wgid / nig, fm = gid * WGM, gsz = (nM - fm) < WGM ? (nM - fm) : WGM;
        u.pm = fm + ((wgid % nig) % gsz); u.pn = (wgid % nig) / gsz; u.bz = 0; return true;
    }
    __device__ __forceinline__ const char* abase(const Gemm& g, const Unit& u) const { return (const char*)g.A + (size_t)u.pm * (size_t)(2 * BM) * g.K; }
    __device__ __forceinline__ const char* bbase(const Gemm& g, const Unit& u) const { return (const char*)g.Bt + (size_t)u.pn * (size_t)(2 * BM) * g.K; }
    __device__ __forceinline__ void a_ready(const Unit&) const {}
    __device__ __forceinline__ void done(const Unit&) const {}
};


template <class Epi, class Sched, bool ALIGN_EPI = false, bool SP2 = false>
__device__ __forceinline__ void gemm_phase(PG8_LAS unsigned char* lds, const Gemm g, const Sched& S, const Epi& E, int tid_in) {
    int tid_ = tid_in; asm volatile("" : "+v"(tid_));
    const int tid = tid_, wid = __builtin_amdgcn_readfirstlane(tid >> 6), lane = tid & 63, wr = wid >> 2, wc = wid & 3, fr = lane & 15, fq = lane >> 4;
    const int K = g.K, nt = K / BK;
    unsigned voffA[2], voffB[2];
#pragma unroll
    for (int i = 0; i < 2; ++i) { int R, C; stage_rc(tid * 16 + i * 8192, R, C); const int Rb = Epi::PERM ? ((R & ~31) + perm32(R & 31)) : R;
        voffA[i] = (unsigned)(R * K + C) * 2u; voffB[i] = (unsigned)(Rb * K + C) * 2u; }
    const size_t kstep = (size_t)(BK * 2);
    const size_t hstep = (size_t)HALF * K * 2;
    const unsigned ldsw = (unsigned)wid * 1024u;
    const int aoff = lds_byte(wr * 64 + fr, fq * 8), boff = lds_byte(wc * 32 + fr, fq * 8);
#define PG8_SA(b, h) (((b) * 2 + (h)) * HTB)
#define PG8_SB(b, h) ((4 + (b) * 2 + (h)) * HTB)
#define PG8_STAGE(bufoff, gbase, voff) do { _Pragma("unroll") for (int _i = 0; _i < 2; ++_i) \
        __builtin_amdgcn_global_load_lds((const unsigned*)((const char*)(gbase) + (voff)[_i]), (PG8_LAS unsigned*)(lds + (bufoff) + ldsw + _i * 8192), 16, 0, 0); } while (0)
#define PG8_LDA(dst, b, h) do { _Pragma("unroll") for (int m = 0; m < 4; ++m) _Pragma("unroll") for (int k = 0; k < 2; ++k) dst[m][k] = *(const PG8_LAS bf16x8*)(lds + PG8_SA(b, h) + aoff + m * 2048 + k * 1024); } while (0)
#define PG8_LDB(dst, b, h) do { _Pragma("unroll") for (int n = 0; n < 2; ++n) _Pragma("unroll") for (int k = 0; k < 2; ++k) dst[n][k] = *(const PG8_LAS bf16x8*)(lds + PG8_SB(b, h) + boff + n * 2048 + k * 1024); } while (0)
#define PG8_MMA(ai, bj, At, Bt) do { __builtin_amdgcn_s_setprio(1); _Pragma("unroll") for (int m = 0; m < 4; ++m) _Pragma("unroll") for (int n = 0; n < 2; ++n) _Pragma("unroll") for (int k = 0; k < 2; ++k) \
        acc[ai][bj][m][n] = __builtin_amdgcn_mfma_f32_16x16x32_bf16(Bt[n][k], At[m][k], acc[ai][bj][m][n], 0, 0, 0); __builtin_amdgcn_s_setprio(0); } while (0)
#define PG8_WAIT_V(n) asm volatile("s_waitcnt vmcnt(" #n ")" ::: "memory")
#define PG8_WAIT_L(n) asm volatile("s_waitcnt lgkmcnt(" #n ")" ::: "memory")
#define PG8_BAR __builtin_amdgcn_s_barrier()
#define PG8_SCHED __builtin_amdgcn_sched_barrier(0)
    Unit cur, nxt; int ui = 0;
    if (!S.next(0, cur)) return;
    f32x4 acc[2][2][4][2];
#pragma unroll
    for (int a = 0; a < 2; ++a)
#pragma unroll
        for (int b = 0; b < 2; ++b)
#pragma unroll
            for (int m = 0; m < 4; ++m)
#pragma unroll
                for (int n = 0; n < 2; ++n) acc[a][b][m][n] = (f32x4){0.f, 0.f, 0.f, 0.f};
    bf16x8 At[4][2], B0[2][2], B1[2][2];
    const char* cA = S.abase(g, cur); const char* cB = S.bbase(g, cur);
    S.a_ready(cur);
    if constexpr (SP2) {
        PG8_STAGE(PG8_SB(0, 0), cB, voffB); PG8_STAGE(PG8_SB(0, 1), cB + hstep, voffB); PG8_STAGE(PG8_SA(0, 0), cA, voffA); PG8_STAGE(PG8_SA(0, 1), cA + hstep, voffA);
        if (wr == 1) PG8_BAR;
        PG8_WAIT_V(2); PG8_BAR;
        PG8_STAGE(PG8_SB(1, 0), cB + kstep, voffB); PG8_STAGE(PG8_SA(1, 0), cA + kstep, voffA); PG8_STAGE(PG8_SB(1, 1), cB + hstep + kstep, voffB);
        PG8_WAIT_V(6); PG8_BAR;
    } else {
        PG8_STAGE(PG8_SB(0, 0), cB, voffB); PG8_STAGE(PG8_SA(0, 0), cA, voffA); PG8_STAGE(PG8_SB(0, 1), cB + hstep, voffB); PG8_STAGE(PG8_SA(0, 1), cA + hstep, voffA);
        if (wr == 1) PG8_BAR;
        PG8_WAIT_V(4); PG8_BAR;
        PG8_STAGE(PG8_SB(1, 0), cB + kstep, voffB); PG8_STAGE(PG8_SA(1, 0), cA + kstep, voffA); PG8_STAGE(PG8_SB(1, 1), cB + hstep + kstep, voffB);
        PG8_WAIT_V(6); PG8_BAR;
    }
    for (;;) {
        const bool has_next = S.next(ui + 1, nxt);
        const char* nA = has_next ? S.abase(g, nxt) : cA; const char* nB = has_next ? S.bbase(g, nxt) : cB;
        for (int t = 0; t < nt; t += 2) {
            const bool last = (t == nt - 2);
            const char* a1 = cA + (size_t)(t + 1) * kstep;
            const char* a2 = last ? nA : cA + (size_t)(t + 2) * kstep; const char* b2 = last ? nB : cB + (size_t)(t + 2) * kstep;
            const char* a3 = a2 + kstep; const char* b3 = b2 + kstep;
            if (last && has_next) S.a_ready(nxt);
            if constexpr (SP2) {
            PG8_LDB(B0, 0, 0); PG8_LDB(B1, 0, 1); PG8_SCHED; PG8_LDA(At, 0, 0); PG8_STAGE(PG8_SA(1, 1), a1 + hstep, voffA);
            PG8_WAIT_V(8); PG8_WAIT_L(0); PG8_BAR; PG8_MMA(0, 0, At, B0); PG8_MMA(0, 1, At, B1); PG8_BAR; PG8_SCHED;
            PG8_LDA(At, 0, 1); PG8_STAGE(PG8_SB(0, 0), b2, voffB); PG8_STAGE(PG8_SB(0, 1), b2 + hstep, voffB); PG8_STAGE(PG8_SA(0, 0), a2, voffA);
            PG8_WAIT_V(8); PG8_WAIT_L(0); PG8_BAR; PG8_MMA(1, 0, At, B0); PG8_MMA(1, 1, At, B1); PG8_BAR; PG8_SCHED;
            PG8_LDB(B0, 1, 0); PG8_LDB(B1, 1, 1); PG8_SCHED; PG8_LDA(At, 1, 0); PG8_STAGE(PG8_SA(0, 1), a2 + hstep, voffA);
            PG8_WAIT_V(8); PG8_WAIT_L(0); PG8_BAR; PG8_MMA(0, 0, At, B0); PG8_MMA(0, 1, At, B1); PG8_BAR; PG8_SCHED;
            PG8_LDA(At, 1, 1); PG8_STAGE(PG8_SB(1, 0), b3, voffB); PG8_STAGE(PG8_SB(1, 1), b3 + hstep, voffB); PG8_STAGE(PG8_SA(1, 0), a3, voffA);
            PG8_WAIT_V(8); PG8_WAIT_L(0); PG8_BAR; PG8_MMA(1, 0, At, B0); PG8_MMA(1, 1, At, B1); PG8_BAR; PG8_SCHED;
            } else {
            PG8_LDB(B0, 0, 0); PG8_SCHED; PG8_LDA(At, 0, 0); PG8_STAGE(PG8_SA(1, 1), a1 + hstep, voffA);
            PG8_WAIT_L(8); PG8_BAR; PG8_WAIT_L(0); PG8_MMA(0, 0, At, B0); PG8_BAR; PG8_SCHED;
            PG8_LDB(B1, 0, 1); PG8_STAGE(PG8_SB(0, 0), b2, voffB);
            PG8_BAR; PG8_WAIT_L(0); PG8_MMA(0, 1, At, B1); PG8_BAR;
            PG8_LDA(At, 0, 1); PG8_STAGE(PG8_SA(0, 0), a2, voffA);
            PG8_BAR; PG8_WAIT_L(0); PG8_MMA(1, 0, At, B0); PG8_BAR; PG8_SCHED;
            PG8_STAGE(PG8_SB(0, 1), b2 + hstep, voffB);
            PG8_WAIT_V(6); PG8_BAR; PG8_MMA(1, 1, At, B1); PG8_BAR;
            PG8_LDB(B0, 1, 0); PG8_SCHED; PG8_LDA(At, 1, 0); PG8_STAGE(PG8_SA(0, 1), a2 + hstep, voffA);
            PG8_WAIT_L(8); PG8_BAR; PG8_WAIT_L(0); PG8_MMA(0, 0, At, B0); PG8_BAR; PG8_SCHED;
            PG8_LDB(B1, 1, 1); PG8_STAGE(PG8_SB(1, 0), b3, voffB);
            PG8_BAR; PG8_WAIT_L(0); PG8_MMA(0, 1, At, B1); PG8_BAR;
            PG8_LDA(At, 1, 1); PG8_STAGE(PG8_SA(1, 0), a3, voffA);
            PG8_BAR; PG8_WAIT_L(0); PG8_MMA(1, 0, At, B0); PG8_BAR; PG8_SCHED;
            PG8_STAGE(PG8_SB(1, 1), b3 + hstep, voffB);
            PG8_WAIT_V(6); PG8_BAR; PG8_MMA(1, 1, At, B1); PG8_BAR;
            }
        }
        if constexpr (ALIGN_EPI) { if (wr == 0) PG8_BAR; }
        if constexpr (Epi::SCALE != 0) E.prescale(acc, cur, wr, wc, fr, fq, lds, tid);
        if constexpr (!Epi::AFTER_DRAIN) { E(acc, cur, wr, wc, fr, fq); S.done(cur); }
        if (!has_next) break;
#pragma unroll
        for (int a = 0; a < 2; ++a)
#pragma unroll
            for (int b = 0; b < 2; ++b)
#pragma unroll
                for (int m = 0; m < 4; ++m)
#pragma unroll
                    for (int n = 0; n < 2; ++n) acc[a][b][m][n] = (f32x4){0.f, 0.f, 0.f, 0.f};
        cur = nxt; cA = nA; cB = nB; ++ui;
        if constexpr (ALIGN_EPI) { if (wr == 1) PG8_BAR; }
    }
    PG8_WAIT_V(0);
    if constexpr (!ALIGN_EPI) { if (wr == 0) PG8_BAR; }
    PG8_BAR;
    if constexpr (Epi::AFTER_DRAIN) { E.fused(acc, cur, wr, wc, fr, fq, lds, wid, lane); S.done(cur); }
#undef PG8_SA
#undef PG8_SB
#undef PG8_STAGE
#undef PG8_LDA
#undef PG8_LDB
#undef PG8_MMA
#undef PG8_WAIT_V
#undef PG8_WAIT_L
#undef PG8_BAR
#undef PG8_SCHED
}

template <class Epi, class Sched>
__device__ __forceinline__ void gemm_phase_simple(const Gemm g, const Sched& S, const Epi& E, int tid_in) {
    int tid_ = tid_in; asm volatile("" : "+v"(tid_));
    const int tid = tid_, wid = __builtin_amdgcn_readfirstlane(tid >> 6), lane = tid & 63, wr = wid >> 2, wc = wid & 3, fr = lane & 15, fq = lane >> 4;
    const int K = g.K;
    Unit cur;
    for (int ui = 0; S.next(ui, cur); ++ui) {
        f32x4 acc[2][2][4][2];
#pragma unroll
        for (int a = 0; a < 2; ++a)
#pragma unroll
            for (int b = 0; b < 2; ++b)
#pragma unroll
                for (int m = 0; m < 4; ++m)
#pragma unroll
                    for (int n = 0; n < 2; ++n) acc[a][b][m][n] = (f32x4){0.f, 0.f, 0.f, 0.f};
        const bf16_t* A0 = (const bf16_t*)S.abase(g, cur); const bf16_t* B0 = (const bf16_t*)S.bbase(g, cur);
        for (int k0 = 0; k0 < K; k0 += 32) {
            bf16x8 Af[2][4], Bf[2][2];
#pragma unroll
            for (int ai = 0; ai < 2; ++ai)
#pragma unroll
                for (int m = 0; m < 4; ++m) Af[ai][m] = *(const bf16x8*)(A0 + (size_t)(ai * 128 + wr * 64 + m * 16 + fr) * K + k0 + 8 * fq);
#pragma unroll
            for (int bj = 0; bj < 2; ++bj)
#pragma unroll
                for (int n = 0; n < 2; ++n) { const int rho = 16 * n + fr, rb = Epi::PERM ? perm32(rho) : rho;
                    Bf[bj][n] = *(const bf16x8*)(B0 + (size_t)(bj * 128 + wc * 32 + rb) * K + k0 + 8 * fq); }
#pragma unroll
            for (int ai = 0; ai < 2; ++ai)
#pragma unroll
                for (int bj = 0; bj < 2; ++bj)
#pragma unroll
                    for (int m = 0; m < 4; ++m)
#pragma unroll
                        for (int n = 0; n < 2; ++n) acc[ai][bj][m][n] = __builtin_amdgcn_mfma_f32_16x16x32_bf16(Bf[bj][n], Af[ai][m], acc[ai][bj][m][n], 0, 0, 0);
        }
        E(acc, cur, wr, wc, fr, fq);
    }
}
}

#define XB_TMO      128
#define XB_XCNT(j)  (256  + 64 * (j))
#define XB_XSUB(j)  (1280 + 64 * (j))
#define XB_XGEN(j)  (2304 + 64 * (j))
#define XB_TOP      3328
#define XB_TOPGEN   3392
#define XCD_BAR_WORDS 3456
#define XB_SPIN_CAP (1u << 22)

__device__ __forceinline__ unsigned xb_ld(unsigned* p)              { return __hip_atomic_load(p, __ATOMIC_RELAXED, __HIP_MEMORY_SCOPE_AGENT); }
__device__ __forceinline__ unsigned xb_add(unsigned* p, unsigned v) { return __hip_atomic_fetch_add(p, v, __ATOMIC_RELAXED, __HIP_MEMORY_SCOPE_AGENT); }
__device__ __forceinline__ unsigned xb_xcc_id() { return (unsigned)__builtin_amdgcn_s_getreg((3 << 11) | 20) & 0xFu; }
#define XB_SPIN(cond, bar) do { unsigned _sp = 0; while (cond) { __builtin_amdgcn_s_sleep(1); \
    if ((++_sp & 255u) == 0u) { if (xb_ld(&(bar)[XB_TMO])) break; if (_sp > XB_SPIN_CAP) { atomicAdd(&(bar)[XB_TMO], 1u); break; } } } } while (0)

struct XcdBarrier {
    unsigned* bar; unsigned x;
    volatile LAS unsigned* st;
};

__device__ __forceinline__ XcdBarrier xcd_barrier_post(unsigned* bar, volatile LAS unsigned* st) {
    XcdBarrier b; b.bar = bar; b.x = xb_xcc_id(); b.st = st;
    if (threadIdx.x == 0) (void)xb_add(&bar[XB_XCNT(b.x)], 1u);
    return b;
}
__device__ __forceinline__ void xcd_barrier_complete(unsigned* bar, unsigned x, unsigned& nloc, unsigned& nx) {
    const unsigned G = gridDim.x * gridDim.y * gridDim.z;
    unsigned sum, cnt, mine, sp = 0u;
    for (;;) {
        sum = 0u; cnt = 0u; mine = 0u;
#pragma unroll
        for (unsigned j = 0; j < 16; ++j) { const unsigned c = xb_ld(&bar[XB_XCNT(j)]); sum += c; cnt += (c > 0u) ? 1u : 0u; mine = (j == x) ? c : mine; }
        if (sum == G) break;
        __builtin_amdgcn_s_sleep(1);
        if ((++sp & 255u) == 0u) { if (xb_ld(&bar[XB_TMO])) break; if (sp > XB_SPIN_CAP) { atomicAdd(&bar[XB_TMO], 1u); break; } }
    }
    nloc = mine > 0u ? mine : 1u; nx = cnt > 0u ? cnt : 1u;
}

__device__ __forceinline__ void xcd_barrier(const XcdBarrier& b) {
    asm volatile("s_waitcnt vmcnt(0)" ::: "memory");
    __syncthreads();
    if (threadIdx.x == 0) {
        unsigned* bar = b.bar;
        __builtin_amdgcn_s_waitcnt(0);
        unsigned nloc = b.st[0], nx = b.st[1];
        if (nloc == 0u) { xcd_barrier_complete(bar, b.x, nloc, nx); b.st[0] = nloc; b.st[1] = nx; }
        const unsigned old = xb_add(&bar[XB_XSUB(b.x)], 1u);
        const unsigned gen = old / nloc;
        if (old + 1u == (gen + 1u) * nloc) {
            __builtin_amdgcn_fence(__ATOMIC_RELEASE, "agent");
            asm volatile("s_waitcnt vmcnt(0)" ::: "memory");
            const unsigned og = xb_add(&bar[XB_TOP], 1u);
            const unsigned tg = og / nx;
            if (og + 1u == (tg + 1u) * nx) xb_add(&bar[XB_TOPGEN], 1u);
            else XB_SPIN(xb_ld(&bar[XB_TOPGEN]) == tg, bar);
            __builtin_amdgcn_fence(__ATOMIC_ACQUIRE, "agent");
            xb_add(&bar[XB_XGEN(b.x)], 1u);
            asm volatile("s_waitcnt vmcnt(0)" ::: "memory");
        } else {
            XB_SPIN(xb_ld(&bar[XB_XGEN(b.x)]) == gen, bar);
            __builtin_amdgcn_fence(__ATOMIC_ACQUIRE, "agent");
            asm volatile("s_waitcnt vmcnt(0)" ::: "memory");
        }
    }
    __syncthreads();
}


using pg8::f32x4; using pg8::u32x4; using pg8::bf16x8;

constexpr int T = 24576, D = 2048, FF = 5504, HG = 1536, FW = 512, NIN = 12288, DEPTH = 4, TP = 8192;
constexpr float EPS = 1e-6f;
#define STAGE_TOL 0.012f
#define CHK_LAYER 1
#define CHK_SKIP 99
#define SCAN_FN phase_scan_fast
#define GEMM_ALIGN true
#define GEMM_SP2 true
#define GEMM_SIMPLE 0
#if GEMM_SIMPLE == 2
#define GEMM_CALL(EPI, SCH) if (run == 0) { pg8::gemm_phase<EPI, SCH, GEMM_ALIGN, GEMM_SP2>(C.lds, g, S, E, C.tid); } else { pg8::gemm_phase_simple<EPI, SCH>(g, S, E, C.tid); }
#elif GEMM_SIMPLE == 1
#define GEMM_CALL(EPI, SCH) pg8::gemm_phase_simple<EPI, SCH>(g, S, E, C.tid);
#else
#define GEMM_CALL(EPI, SCH) pg8::gemm_phase<EPI, SCH, GEMM_ALIGN, GEMM_SP2>(C.lds, g, S, E, C.tid);
#endif
#ifndef MK_MULTI
#define MK_MULTI 0
#endif
#ifdef STAGE_CHECK
constexpr int NPH_LAYER = 24;
#else
constexpr int NPH_LAYER = 10;
#endif
#ifdef CSUM_CHECK
constexpr int NPH = 2 * 2 * (1 + NPH_LAYER * DEPTH + 1) + 1 + 2 * 2 * DEPTH;
#else
#ifdef CMP_G3
constexpr int NPH = 1 + (NPH_LAYER + 1) * DEPTH + 1;
#else
constexpr int NPH = 2 + NPH_LAYER * DEPTH + 1;
#endif
#endif

constexpr size_t WS_CTL = 0, CTL_BYTES = 1u << 20;
constexpr size_t WS_LB = WS_CTL + CTL_BYTES;
constexpr size_t SZ_WI = (size_t)2 * FF * D * 2, SZ_WD = (size_t)D * FF * 2;
constexpr size_t WS_W1I = WS_LB + 65536;
constexpr size_t WS_W1D = WS_W1I + SZ_WI;
constexpr size_t WS_WIN = WS_W1D + SZ_WD;
constexpr size_t WS_WFO = WS_WIN + (size_t)NIN * D * 2;
constexpr size_t WS_WHO = WS_WFO + (size_t)D * FW * 2;
constexpr size_t WS_WOU = WS_WHO + (size_t)D * HG * 2;
constexpr size_t WS_W2I = WS_WOU + (size_t)D * D * 2;
constexpr size_t WS_W2D = WS_W2I + SZ_WI;
constexpr size_t WS_DM8 = WS_W2D + SZ_WD;
constexpr size_t WS_X16 = WS_DM8 + (size_t)2 * 4096 * 8192 * 2;
static_assert(WS_X16 + (size_t)24576 * 2048 * 2 <= WS_DM8 + (size_t)8192 * 16384 * 2, "X16 fits behind the DFT matrices");
constexpr size_t WS_DM2 = WS_DM8 + (size_t)8192 * 16384 * 2;
constexpr size_t WS_U = WS_DM2 + (size_t)2048 * 4096 * 2;
constexpr size_t WS_BIG = WS_U + (size_t)T * D * 2;
constexpr size_t WS_H = WS_BIG;
constexpr size_t WS_PQT = WS_BIG;
constexpr size_t WS_QS = WS_PQT + (size_t)T * 1024 * 2;
constexpr size_t WS_VV = WS_QS + (size_t)T * HG * 2;
constexpr size_t WS_GO = WS_VV + (size_t)T * HG * 2;
constexpr size_t WS_SA = WS_GO + (size_t)T * HG * 2;
constexpr size_t WS_SB = WS_SA + (size_t)T * D * 2;
constexpr size_t WS_LF = WS_SB + (size_t)T * D * 2;
constexpr size_t WS_PP = WS_LF;
constexpr size_t WS_MG = WS_PP + (size_t)T * D * 4;
constexpr size_t WS_BIG_END = WS_LF + (size_t)2 * T * HG * 4;
static_assert(WS_MG + (size_t)T * D * 2 <= WS_BIG_END, "alias map");
static_assert(WS_H + (size_t)T * FF * 2 <= WS_BIG_END, "alias map");
constexpr size_t WS_OF = WS_BIG_END;
constexpr size_t WS_OO = WS_OF + (size_t)T * HG * 4;
constexpr size_t WS_YY = WS_OO + (size_t)T * HG * 2;
constexpr size_t WS_OB = WS_YY + (size_t)T * FW * 2;
constexpr size_t WS_EB = WS_OB + (size_t)T * HG * 4;
constexpr size_t WS_LS = WS_EB + (size_t)144 * 16384 * 4;
constexpr size_t WS_RS = WS_LS + (size_t)144 * 128 * 4;
constexpr size_t WS_END = WS_RS + (size_t)24576 * 32 * 4;
constexpr int CW_BAR = 4096;
constexpr int LDS_BYTES = 147456, LDS_BAR_OFF = 131072;

struct Args { const float* in[16]; float* out; unsigned char* ws; int ph_lo, ph_hi; };
__device__ __forceinline__ float bf2f(unsigned short h) { return __uint_as_float(((unsigned)h) << 16); }
__device__ __forceinline__ unsigned pk2(float lo, float hi) { unsigned r; asm volatile("v_cvt_pk_bf16_f32 %0, %1, %2" : "=v"(r) : "v"(lo), "v"(hi)); return r; }
__device__ __forceinline__ float sigm(float x) { return __builtin_amdgcn_rcpf(1.0f + __expf(-x)); }
__device__ __forceinline__ float siluf(float x) { return x * sigm(x); }
__device__ __forceinline__ float wave_sum(float v, int lane) {
#pragma unroll
    for (int o = 1; o < 64; o <<= 1) v += __builtin_bit_cast(float, __builtin_amdgcn_ds_bpermute((lane ^ o) << 2, __builtin_bit_cast(int, v)));
    return v;
}
__device__ __forceinline__ const LAS float* rstd_panel(const float* RS, int panel_, LAS unsigned char* lds, int tid_) {
    int tid = tid_, panel = panel_; asm volatile("" : "+s"(panel));
    LAS float* rc = (LAS float*)(lds + LDS_BAR_OFF + 1024); volatile LAS int* tag = (volatile LAS int*)(lds + LDS_BAR_OFF + 64);
    asm volatile("" : "+v"(tid));
    if (*tag != panel) {
        __syncthreads();
        const f32x4* p4 = (const f32x4*)(RS + ((size_t)panel * 256 + (tid >> 1)) * 32 + (tid & 1) * 16);
        const f32x4 a0 = p4[0], a1 = p4[1], a2 = p4[2], a3 = p4[3];
        float sm = ((a0.x + a0.y) + (a0.z + a0.w)) + ((a1.x + a1.y) + (a1.z + a1.w)) + ((a2.x + a2.y) + (a2.z + a2.w)) + ((a3.x + a3.y) + (a3.z + a3.w));
        sm += __builtin_bit_cast(float, __builtin_amdgcn_ds_bpermute(((tid & 63) ^ 1) << 2, __builtin_bit_cast(int, sm)));
        if ((tid & 1) == 0) rc[tid >> 1] = 1.0f / sqrtf(sm * (1.0f / D) + EPS);
        if (tid == 0) *tag = panel;
        __syncthreads();
    }
    return rc;
}
#define LDS_WAIT() asm volatile("s_waitcnt lgkmcnt(0)" ::: "memory")

struct BatchOrder {
    int nM, nN, nb, G, c; size_t bstride;
    __device__ __forceinline__ bool next(int i, pg8::Unit& u) const {
        const long L = (long)i * G + c; const int per = nM * nN; if (L >= (long)nb * per) return false;
        u.bz = (int)(L / per); const int r = (int)(L % per); u.pm = r / nN; u.pn = r % nN; return true;
    }
    __device__ __forceinline__ const char* abase(const pg8::Gemm& g, const pg8::Unit& u) const { return (const char*)g.A + (size_t)u.pm * (size_t)512 * g.K; }
    __device__ __forceinline__ const char* bbase(const pg8::Gemm& g, const pg8::Unit& u) const { return (const char*)g.Bt + (size_t)u.bz * bstride + (size_t)u.pn * (size_t)512 * g.K; }
    __device__ __forceinline__ void a_ready(const pg8::Unit&) const {}
    __device__ __forceinline__ void done(const pg8::Unit&) const {}
};

#define ACC_T const f32x4 (&acc)[2][2][4][2]

__device__ __forceinline__ void row_prescale(f32x4 (&acc)[2][2][4][2], const float* RS, int panel, int wr, int fr, LAS unsigned char* lds, int tid) {
    const LAS float* rc = rstd_panel(RS, panel, lds, tid);
    int frl = fr; asm volatile("" : "+v"(frl));
#pragma unroll
    for (int ai = 0; ai < 2; ++ai)
#pragma unroll
        for (int m = 0; m < 4; ++m) { const float r = rc[ai * 128 + wr * 64 + m * 16 + frl];
#pragma unroll
            for (int bj = 0; bj < 2; ++bj) { acc[ai][bj][m][0] *= r; acc[ai][bj][m][1] *= r; } }
}
__device__ __forceinline__ void col_prescale(f32x4 (&acc)[2][2][4][2], const float* RS, int panel, int wc, int fq, LAS unsigned char* lds, int tid) {
    const LAS float* rc = rstd_panel(RS, panel, lds, tid);
    int fql = fq; asm volatile("" : "+v"(fql));
#pragma unroll
    for (int bj = 0; bj < 2; ++bj)
#pragma unroll
        for (int n = 0; n < 2; ++n) { const f32x4 r = *(const LAS f32x4*)(rc + bj * 128 + wc * 32 + 8 * fql + 4 * n);
#pragma unroll
            for (int ai = 0; ai < 2; ++ai)
#pragma unroll
                for (int m = 0; m < 4; ++m) acc[ai][bj][m][n] *= r; }
}
struct EpiSwiglu {
    static constexpr bool PERM = true, AFTER_DRAIN = false; static constexpr int SCALE = 1;
    unsigned char* ws;
    __device__ __forceinline__ void prescale(f32x4 (&acc)[2][2][4][2], const pg8::Unit& u, int wr, int wc, int fr, int fq, LAS unsigned char* lds, int tid) const { row_prescale(acc, (const float*)(ws + WS_RS), u.pm, wr, fr, lds, tid); }
    __device__ __forceinline__ void operator()(ACC_T, const pg8::Unit& u, int wr, int wc, int fr, int fq) const {
        bf16* H = (bf16*)(ws + WS_H);
        const int row0 = u.pm * 256 + wr * 64 + fr, col0 = u.pn * 128 + wc * 32 + 8 * fq;
#pragma unroll
        for (int ai = 0; ai < 2; ++ai)
#pragma unroll
            for (int m = 0; m < 4; ++m) {
                bf16* rowp = H + (size_t)(row0 + ai * 128 + m * 16) * FF + col0;
                const f32x4 g0 = acc[ai][0][m][0], g1 = acc[ai][0][m][1], u0 = acc[ai][1][m][0], u1 = acc[ai][1][m][1];
                u32x4 w;
                w.x = pk2(siluf(g0[0]) * u0[0], siluf(g0[1]) * u0[1]); w.y = pk2(siluf(g0[2]) * u0[2], siluf(g0[3]) * u0[3]);
                w.z = pk2(siluf(g1[0]) * u1[0], siluf(g1[1]) * u1[1]); w.w = pk2(siluf(g1[2]) * u1[2], siluf(g1[3]) * u1[3]);
                *(u32x4*)rowp = w;
            }
    }
};

struct EpiResid {
    static constexpr bool PERM = true, AFTER_DRAIN = false; static constexpr int SCALE = 0;
    const float* xp; const float* xs; bf16* x16; float scale; float* rs;
    __device__ __forceinline__ void operator()(ACC_T, const pg8::Unit& u, int wr, int wc, int fr, int fq) const {
        const int row0 = u.pm * 256 + wr * 64 + fr, col0 = u.pn * 256 + wc * 32 + 8 * fq;
        float sq[2][4];
#pragma unroll
        for (int ai = 0; ai < 2; ++ai)
#pragma unroll
            for (int m = 0; m < 4; ++m) sq[ai][m] = 0.f;
        if (xp != nullptr) {
#pragma unroll
            for (int ai = 0; ai < 2; ++ai)
#pragma unroll
                for (int mp = 0; mp < 2; ++mp) {
                    f32x4 xv[2][2][2];
#pragma unroll
                    for (int mm = 0; mm < 2; ++mm) { const int row = row0 + ai * 128 + (2 * mp + mm) * 16;
                        const float* src = (row < TP ? xp + (size_t)row * D : xs + (size_t)(row - TP) * D) + col0;
#pragma unroll
                        for (int bj = 0; bj < 2; ++bj)
#pragma unroll
                            for (int n = 0; n < 2; ++n) xv[mm][bj][n] = *(const f32x4*)(src + bj * 128 + 4 * n); }
#pragma unroll
                    for (int mm = 0; mm < 2; ++mm) { const int m = 2 * mp + mm, row = row0 + ai * 128 + m * 16; bf16* dst = x16 + (size_t)row * D + col0;
#pragma unroll
                        for (int bj = 0; bj < 2; ++bj) { const f32x4 v0 = xv[mm][bj][0] + acc[ai][bj][m][0] * scale, v1 = xv[mm][bj][1] + acc[ai][bj][m][1] * scale;
                            sq[ai][m] += ((v0[0] * v0[0] + v0[1] * v0[1]) + (v0[2] * v0[2] + v0[3] * v0[3])) + ((v1[0] * v1[0] + v1[1] * v1[1]) + (v1[2] * v1[2] + v1[3] * v1[3]));
                            u32x4 w; w.x = pk2(v0[0], v0[1]); w.y = pk2(v0[2], v0[3]); w.z = pk2(v1[0], v1[1]); w.w = pk2(v1[2], v1[3]); *(u32x4*)(dst + bj * 128) = w; __builtin_amdgcn_sched_barrier(0); } }
                }
        } else {
#pragma unroll
            for (int ai = 0; ai < 2; ++ai) {
                u32x4 xv[4][2];
#pragma unroll
                for (int m = 0; m < 4; ++m)
#pragma unroll
                    for (int bj = 0; bj < 2; ++bj) xv[m][bj] = *(const u32x4*)(x16 + (size_t)(row0 + ai * 128 + m * 16) * D + col0 + bj * 128);
#pragma unroll
                for (int m = 0; m < 4; ++m)
#pragma unroll
                    for (int bj = 0; bj < 2; ++bj) { const u32x4 pv = xv[m][bj];
                        const f32x4 q0 = {__uint_as_float(pv.x << 16), __uint_as_float(pv.x & 0xffff0000u), __uint_as_float(pv.y << 16), __uint_as_float(pv.y & 0xffff0000u)};
                        const f32x4 q1 = {__uint_as_float(pv.z << 16), __uint_as_float(pv.z & 0xffff0000u), __uint_as_float(pv.w << 16), __uint_as_float(pv.w & 0xffff0000u)};
                        const f32x4 v0 = q0 + acc[ai][bj][m][0] * scale, v1 = q1 + acc[ai][bj][m][1] * scale;
                        sq[ai][m] += ((v0[0] * v0[0] + v0[1] * v0[1]) + (v0[2] * v0[2] + v0[3] * v0[3])) + ((v1[0] * v1[0] + v1[1] * v1[1]) + (v1[2] * v1[2] + v1[3] * v1[3]));
                        u32x4 w; w.x = pk2(v0[0], v0[1]); w.y = pk2(v0[2], v0[3]); w.z = pk2(v1[0], v1[1]); w.w = pk2(v1[2], v1[3]);
                        *(u32x4*)(x16 + (size_t)(row0 + ai * 128 + m * 16) * D + col0 + bj * 128) = w; }
            }
        }
        const int ln = fq * 16 + fr;
#pragma unroll
        for (int ai = 0; ai < 2; ++ai)
#pragma unroll
            for (int m = 0; m < 4; ++m) { float v = sq[ai][m];
                v += __builtin_bit_cast(float, __builtin_amdgcn_ds_bpermute((ln ^ 16) << 2, __builtin_bit_cast(int, v)));
                v += __builtin_bit_cast(float, __builtin_amdgcn_ds_bpermute((ln ^ 32) << 2, __builtin_bit_cast(int, v)));
                if (fq == 0) rs[(size_t)(row0 + ai * 128 + m * 16) * 32 + u.pn * 4 + wc] = v; }
    }
};

template <int ACT>
__device__ __forceinline__ void store_tile_bf16(ACC_T, bf16* dst, int ld, int row0, int col0, int cmp = 0, unsigned* cnt = nullptr) {
#pragma unroll
    for (int ai = 0; ai < 2; ++ai)
#pragma unroll
        for (int m = 0; m < 4; ++m) {
            bf16* rowp = dst + (size_t)(row0 + ai * 128 + m * 16) * ld + col0;
#pragma unroll
            for (int bj = 0; bj < 2; ++bj) {
                f32x4 v0 = acc[ai][bj][m][0], v1 = acc[ai][bj][m][1];
                if (ACT == 1) {
#pragma unroll
                    for (int j = 0; j < 4; ++j) { v0[j] = siluf(v0[j]); v1[j] = siluf(v1[j]); } }
                if (ACT == 2) {
#pragma unroll
                    for (int j = 0; j < 4; ++j) { v0[j] = sigm(v0[j]); v1[j] = sigm(v1[j]); } }
                u32x4 w; w.x = pk2(v0[0], v0[1]); w.y = pk2(v0[2], v0[3]); w.z = pk2(v1[0], v1[1]); w.w = pk2(v1[2], v1[3]);
                if (cmp) { const u32x4 o_ = *(const u32x4*)(rowp + bj * 128); if (o_.x != w.x || o_.y != w.y || o_.z != w.z || o_.w != w.w) { atomicAdd(cnt, 1u);
                    float md = 0.f; const unsigned ow[4] = {o_.x, o_.y, o_.z, o_.w}, nw[4] = {w.x, w.y, w.z, w.w};
#pragma unroll
                    for (int q_ = 0; q_ < 4; ++q_) { md = fmaxf(md, fabsf(__uint_as_float(ow[q_] << 16) - __uint_as_float(nw[q_] << 16))); md = fmaxf(md, fabsf(__uint_as_float(ow[q_] & 0xffff0000u) - __uint_as_float(nw[q_] & 0xffff0000u))); }
                    atomicMax(cnt + 16, __float_as_uint(md)); } }
                else *(u32x4*)(rowp + bj * 128) = w;
            }
        }
}


__device__ __forceinline__ void store_tile_bf16_rt(ACC_T, bf16* dst, int ld, int row0, int col0, int act) {
    const float ks = act == 2 ? 0.0f : 1.0f, kx = act == 0 ? 1.0f : 0.0f;
#pragma unroll
    for (int ai = 0; ai < 2; ++ai)
#pragma unroll
        for (int m = 0; m < 4; ++m) {
            bf16* rowp = dst + (size_t)(row0 + ai * 128 + m * 16) * ld + col0;
#pragma unroll
            for (int bj = 0; bj < 2; ++bj) {
                f32x4 v0 = acc[ai][bj][m][0], v1 = acc[ai][bj][m][1];
#pragma unroll
                for (int j = 0; j < 4; ++j) {
                    const float s0 = sigm(v0[j]), s1 = sigm(v1[j]);
                    const float a0 = (ks * v0[j] + (1.0f - ks)) * s0, a1 = (ks * v1[j] + (1.0f - ks)) * s1;
                    v0[j] = act == 0 ? v0[j] : a0; v1[j] = act == 0 ? v1[j] : a1; }
                (void)kx;
                u32x4 w; w.x = pk2(v0[0], v0[1]); w.y = pk2(v0[2], v0[3]); w.z = pk2(v1[0], v1[1]); w.w = pk2(v1[2], v1[3]);
                *(u32x4*)(rowp + bj * 128) = w;
            }
        }
}
struct FourierOrder {
    int c;
    __device__ __forceinline__ bool next(int i, pg8::Unit& u) const { if (i > 0 || c >= 192) return false; u.pm = c & 1; u.pn = c >> 1; u.bz = 0; return true; }
    __device__ __forceinline__ const char* abase(const pg8::Gemm& g, const pg8::Unit& u) const { return (const char*)g.A + (size_t)u.pm * (size_t)512 * g.K; }
    __device__ __forceinline__ const char* bbase(const pg8::Gemm& g, const pg8::Unit& u) const { return (const char*)g.Bt + (size_t)u.pn * (size_t)512 * g.K; }
    __device__ __forceinline__ void a_ready(const pg8::Unit&) const {}
    __device__ __forceinline__ void done(const pg8::Unit&) const {}
};
struct EpiFourier {
    static constexpr bool PERM = true, AFTER_DRAIN = false; static constexpr int SCALE = 2;
    unsigned char* ws;
    __device__ __forceinline__ void prescale(f32x4 (&acc)[2][2][4][2], const pg8::Unit& u, int wr, int wc, int fr, int fq, LAS unsigned char* lds, int tid) const { col_prescale(acc, (const float*)(ws + WS_RS), u.pn, wc, fq, lds, tid); }
    __device__ __forceinline__ void operator()(ACC_T, const pg8::Unit& u, int wr, int wc, int fr, int fq) const {
        bf16* PQT = (bf16*)(ws + WS_PQT);
        const int t0 = u.pn * 256; int S, sbase; bf16* pq;
        if (t0 < TP) { S = 2048; const int b = t0 >> 11; sbase = b * 2048; pq = PQT + (size_t)b * 512 * 4096; }
        else { S = 8192; const int b = (t0 - TP) >> 13; sbase = TP + b * 8192; pq = PQT + (size_t)4 * 512 * 4096 + (size_t)b * 512 * 16384; }
        const unsigned Su = (unsigned)S, pos0 = (unsigned)(t0 - sbase + wc * 32 + 8 * fq);
#pragma unroll
        for (int ai = 0; ai < 2; ++ai)
#pragma unroll
            for (int m = 0; m < 4; ++m) {
                const int jj = 64 * wr + 16 * m + fr, z = jj > 64 ? 1 : 0, c = jj - 64 * z, rg = 128 * (2 * u.pm + ai); const bool sp = (jj == 0) || (jj == 64);
                const unsigned o1 = (unsigned)(z * 512 + rg + c) * Su + pos0, o2 = (unsigned)((sp ? 512 + c : z * 512 + 128 - c) + rg) * Su + pos0;
                const unsigned keep = sp ? 0u : 0xffffffffu, sg = z ? 0x80008000u : 0u;
#pragma unroll
                for (int bj = 0; bj < 2; ++bj) { const f32x4 v0 = acc[ai][bj][m][0], v1 = acc[ai][bj][m][1];
                    u32x4 w; w.x = pk2(v0[0], v0[1]); w.y = pk2(v0[2], v0[3]); w.z = pk2(v1[0], v1[1]); w.w = pk2(v1[2], v1[3]);
                    *(u32x4*)(pq + o1 + bj * 128) = w;
                    u32x4 w2; w2.x = (w.x ^ sg) & keep; w2.y = (w.y ^ sg) & keep; w2.z = (w.z ^ sg) & keep; w2.w = (w.w ^ sg) & keep;
                    *(u32x4*)(pq + o2 + bj * 128) = w2; }
            }
    }
};
struct EpiMixIn {
    static constexpr bool PERM = true, AFTER_DRAIN = false; static constexpr int SCALE = 1;
    unsigned char* ws; int l; int cmp; unsigned* cnt;
    __device__ __forceinline__ void prescale(f32x4 (&acc)[2][2][4][2], const pg8::Unit& u, int wr, int wc, int fr, int fq, LAS unsigned char* lds, int tid) const { row_prescale(acc, (const float*)(ws + WS_RS), u.pm, wr, fr, lds, tid); }
    __device__ __forceinline__ void operator()(ACC_T, const pg8::Unit& u, int wr, int wc, int fr, int fq) const {
        bf16* PQT = (bf16*)(ws + WS_PQT); bf16* QS = (bf16*)(ws + WS_QS); bf16* VV = (bf16*)(ws + WS_VV); bf16* GO = (bf16*)(ws + WS_GO); bf16* SA = (bf16*)(ws + WS_SA); bf16* SB = (bf16*)(ws + WS_SB);
        float* LF = (float*)(ws + WS_LF); const float* lbf = (const float*)(ws + WS_LB) + (size_t)l * HG; const float* lbb = lbf + (size_t)4 * HG;
        const int pn = u.pn + 2, row0 = u.pm * 256 + wr * 64 + fr, cw = wc * 32 + 8 * fq;
        if (pn >= 8 && pn < 20) {
            const int dir = pn >= 14, col0 = (pn - (dir ? 14 : 8)) * 256 + cw;
            const float* lb = dir ? lbb : lbf; float* dst = LF + (size_t)dir * T * HG;
            f32x4 lbv[2][2];
#pragma unroll
            for (int bj = 0; bj < 2; ++bj)
#pragma unroll
                for (int n = 0; n < 2; ++n) lbv[bj][n] = *(const f32x4*)(lb + col0 + bj * 128 + 4 * n);
#pragma unroll
            for (int ai = 0; ai < 2; ++ai)
#pragma unroll
                for (int m = 0; m < 4; ++m) {
                    float* rowp = dst + (size_t)(row0 + ai * 128 + m * 16) * HG + col0;
#pragma unroll
                    for (int bj = 0; bj < 2; ++bj)
#pragma unroll
                        for (int n = 0; n < 2; ++n) {
                            const f32x4 z = acc[ai][bj][m][n]; f32x4 o;
#pragma unroll
                            for (int j = 0; j < 4; ++j) { const float l = lbv[bj][n][j]; const float f = l + (1.0f - l) * sigm(z[j]); o[j] = __logf(fmaxf(f, 1e-30f)); }
                            if (cmp) { const f32x4 o_ = *(const f32x4*)(rowp + bj * 128 + 4 * n); if (o_[0] != o[0] || o_[1] != o[1] || o_[2] != o[2] || o_[3] != o[3]) atomicAdd(cnt + 2, 1u); } else
                            *(f32x4*)(rowp + bj * 128 + 4 * n) = o;
                        }
                }
        } else {
            const int seg = pn < 8 ? 0 : pn < 26 ? 1 : pn < 32 ? 2 : pn < 40 ? 3 : 4;
            const int pn0 = seg == 0 ? 2 : seg == 1 ? 20 : seg == 2 ? 26 : seg == 3 ? 32 : 40;
            const size_t off = seg == 0 ? WS_QS : seg == 1 ? WS_VV : seg == 2 ? WS_GO : seg == 3 ? WS_SA : WS_SB;
            store_tile_bf16_rt(acc, (bf16*)(ws + off), seg < 3 ? HG : D, row0, (pn - pn0) * 256 + cw, seg == 1 ? 0 : seg < 3 ? 1 : 2);
        }
    }
};


struct EpiRaw {
    static constexpr bool PERM = true, AFTER_DRAIN = false; static constexpr int SCALE = 0;
    unsigned char* ws;
    __device__ __forceinline__ void operator()(ACC_T, const pg8::Unit& u, int wr, int wc, int fr, int fq) const {
        store_tile_bf16<0>(acc, (bf16*)(ws + WS_PQT), NIN, u.pm * 256 + wr * 64 + fr, u.pn * 256 + wc * 32 + 8 * fq);
    }
};
struct EpiDft {
    static constexpr bool PERM = true, AFTER_DRAIN = false; static constexpr int SCALE = 0;
    unsigned char* ws; int sbase0, sstride; float scale;
    __device__ __forceinline__ void operator()(ACC_T, const pg8::Unit& u, int wr, int wc, int fr, int fq) const {
        bf16* Y = (bf16*)(ws + WS_YY);
        const int row0 = sbase0 + u.bz * sstride + u.pm * 256 + wr * 64 + fr, col0 = u.pn * 256 + wc * 32 + 8 * fq;
#pragma unroll
        for (int ai = 0; ai < 2; ++ai)
#pragma unroll
            for (int m = 0; m < 4; ++m) {
                bf16* rowp = Y + (size_t)(row0 + ai * 128 + m * 16) * FW + col0;
#pragma unroll
                for (int bj = 0; bj < 2; ++bj) {
                    const f32x4 v0 = acc[ai][bj][m][0] * scale, v1 = acc[ai][bj][m][1] * scale;
                    u32x4 w; w.x = pk2(v0[0], v0[1]); w.y = pk2(v0[2], v0[3]); w.z = pk2(v1[0], v1[1]); w.w = pk2(v1[2], v1[3]);
                    *(u32x4*)(rowp + bj * 128) = w;
                }
            }
    }
};

struct DftOrder {
    int nM, nb, G, c; size_t bstride, astride;
    __device__ __forceinline__ bool next(int i, pg8::Unit& u) const {
        const long L = (long)i * G + c; const int per = nM * 2; if (L >= (long)nb * per) return false;
        u.bz = (int)(L / per); const int r = (int)(L % per); u.pm = r >> 1; u.pn = r & 1; return true;
    }
    __device__ __forceinline__ const char* abase(const pg8::Gemm& g, const pg8::Unit& u) const { return (const char*)g.A + (size_t)(u.bz & 1) * astride + (size_t)u.pm * (size_t)512 * g.K; }
    __device__ __forceinline__ const char* bbase(const pg8::Gemm& g, const pg8::Unit& u) const { return (const char*)g.Bt + (size_t)u.bz * bstride + (size_t)u.pn * (size_t)512 * g.K; }
    __device__ __forceinline__ void a_ready(const pg8::Unit&) const {}
    __device__ __forceinline__ void done(const pg8::Unit&) const {}
};
struct EpiDftH {
    static constexpr bool PERM = true, AFTER_DRAIN = false; static constexpr int SCALE = 0;
    unsigned char* ws; int rbase0, rstride; float scale;
    __device__ __forceinline__ void operator()(ACC_T, const pg8::Unit& u, int wr, int wc, int fr, int fq) const {
        float* AB = (float*)(ws + WS_U) + (size_t)(u.bz & 1) * (T / 2) * FW;
        const int row0 = rbase0 + (u.bz >> 1) * rstride + u.pm * 256 + wr * 64 + fr, col0 = u.pn * 256 + wc * 32 + 8 * fq;
#pragma unroll
        for (int ai = 0; ai < 2; ++ai)
#pragma unroll
            for (int m = 0; m < 4; ++m) {
                float* rowp = AB + (size_t)(row0 + ai * 128 + m * 16) * FW + col0;
#pragma unroll
                for (int bj = 0; bj < 2; ++bj) { *(f32x4*)(rowp + bj * 128) = acc[ai][bj][m][0] * scale; *(f32x4*)(rowp + bj * 128 + 4) = acc[ai][bj][m][1] * scale; }
            }
    }
};

struct EpiBranchA {
    static constexpr bool PERM = true, AFTER_DRAIN = false; static constexpr int SCALE = 0;
    unsigned char* ws;
    __device__ __forceinline__ void operator()(ACC_T, const pg8::Unit& u, int wr, int wc, int fr, int fq) const {
        const bf16* SA = (const bf16*)(ws + WS_SA); bf16* P = (bf16*)(ws + WS_PP);
        const int row0 = u.pm * 256 + wr * 64 + fr, col0 = u.pn * 256 + wc * 32 + 8 * fq;
#pragma unroll
        for (int ai = 0; ai < 2; ++ai) {
            u32x4 g[4][2];
#pragma unroll
            for (int m = 0; m < 4; ++m)
#pragma unroll
                for (int bj = 0; bj < 2; ++bj) g[m][bj] = *(const u32x4*)(SA + (size_t)(row0 + ai * 128 + m * 16) * D + col0 + bj * 128);
#pragma unroll
            for (int m = 0; m < 4; ++m) { const size_t off = (size_t)(row0 + ai * 128 + m * 16) * D + col0;
#pragma unroll
                for (int bj = 0; bj < 2; ++bj) { const u32x4 gv = g[m][bj];
                    const f32x4 g0 = {__uint_as_float(gv.x << 16), __uint_as_float(gv.x & 0xffff0000u), __uint_as_float(gv.y << 16), __uint_as_float(gv.y & 0xffff0000u)};
                    const f32x4 g1 = {__uint_as_float(gv.z << 16), __uint_as_float(gv.z & 0xffff0000u), __uint_as_float(gv.w << 16), __uint_as_float(gv.w & 0xffff0000u)};
                    const f32x4 v0 = g0 * acc[ai][bj][m][0], v1 = g1 * acc[ai][bj][m][1];
                    u32x4 w; w.x = pk2(v0[0], v0[1]); w.y = pk2(v0[2], v0[3]); w.z = pk2(v1[0], v1[1]); w.w = pk2(v1[2], v1[3]);
                    *(u32x4*)(P + off + bj * 128) = w; } }
        }
    }
};
struct EpiBranchB {
    static constexpr bool PERM = true, AFTER_DRAIN = false; static constexpr int SCALE = 0;
    unsigned char* ws;
    __device__ __forceinline__ void operator()(ACC_T, const pg8::Unit& u, int wr, int wc, int fr, int fq) const {
        const bf16* SB = (const bf16*)(ws + WS_SB); const bf16* P = (const bf16*)(ws + WS_PP); bf16* MG = (bf16*)(ws + WS_MG);
        const int row0 = u.pm * 256 + wr * 64 + fr, col0 = u.pn * 256 + wc * 32 + 8 * fq;
#pragma unroll
        for (int ai = 0; ai < 2; ++ai)
#pragma unroll
            for (int mp = 0; mp < 2; ++mp) {
                u32x4 g[2][2], pp[2][2];
#pragma unroll
                for (int mm = 0; mm < 2; ++mm) { const size_t off = (size_t)(row0 + ai * 128 + (2 * mp + mm) * 16) * D + col0;
#pragma unroll
                    for (int bj = 0; bj < 2; ++bj) { g[mm][bj] = *(const u32x4*)(SB + off + bj * 128); pp[mm][bj] = *(const u32x4*)(P + off + bj * 128); } }
#pragma unroll
                for (int mm = 0; mm < 2; ++mm) { const int m = 2 * mp + mm; const size_t off = (size_t)(row0 + ai * 128 + m * 16) * D + col0;
#pragma unroll
                    for (int bj = 0; bj < 2; ++bj) { const u32x4 gv = g[mm][bj];
                        const f32x4 g0 = {__uint_as_float(gv.x << 16), __uint_as_float(gv.x & 0xffff0000u), __uint_as_float(gv.y << 16), __uint_as_float(gv.y & 0xffff0000u)};
                        const f32x4 g1 = {__uint_as_float(gv.z << 16), __uint_as_float(gv.z & 0xffff0000u), __uint_as_float(gv.w << 16), __uint_as_float(gv.w & 0xffff0000u)};
                        const u32x4 pv = pp[mm][bj];
                        const f32x4 q0 = {__uint_as_float(pv.x << 16), __uint_as_float(pv.x & 0xffff0000u), __uint_as_float(pv.y << 16), __uint_as_float(pv.y & 0xffff0000u)};
                        const f32x4 q1 = {__uint_as_float(pv.z << 16), __uint_as_float(pv.z & 0xffff0000u), __uint_as_float(pv.w << 16), __uint_as_float(pv.w & 0xffff0000u)};
                        const f32x4 v0 = q0 + g0 * acc[ai][bj][m][0], v1 = q1 + g1 * acc[ai][bj][m][1];
                        u32x4 w; w.x = pk2(v0[0], v0[1]); w.y = pk2(v0[2], v0[3]); w.z = pk2(v1[0], v1[1]); w.w = pk2(v1[2], v1[3]);
                        *(u32x4*)(MG + off + bj * 128) = w; } }
            }
    }
};

typedef const __attribute__((address_space(4))) Args ArgsK; typedef ArgsK* ArgsP;
struct Ctx { LAS unsigned char* lds; int tid, lane, wave, G, vcu, gw, NGW; };

__device__ __forceinline__ void conv_item(const float* W, int K, int Nsrc, int nsrc0, bf16* WT, int nrow0, int k0, LAS float* scr, int lane, const float* gk = nullptr) {
    { f32x4 v[8]; const int c4 = (lane & 7) * 4;
#pragma unroll
      for (int i = 0; i < 8; ++i) v[i] = *(const f32x4*)(W + (size_t)(k0 + 8 * i + (lane >> 3)) * Nsrc + nsrc0 + c4);
      if (gk != nullptr) {
#pragma unroll
        for (int i = 0; i < 8; ++i) v[i] *= gk[k0 + 8 * i + (lane >> 3)]; }
#pragma unroll
      for (int i = 0; i < 8; ++i) { LAS float* d = scr + (8 * i + (lane >> 3)) * 33 + c4; d[0] = v[i].x; d[1] = v[i].y; d[2] = v[i].z; d[3] = v[i].w; } }
    LDS_WAIT();
    const int c = lane & 7;
#pragma unroll
    for (int j = 0; j < 4; ++j) { const int n = (lane >> 3) + 8 * j; const LAS float* s = scr + (8 * c) * 33 + n;
        u32x4 o; o.x = pk2(s[0 * 33], s[1 * 33]); o.y = pk2(s[2 * 33], s[3 * 33]); o.z = pk2(s[4 * 33], s[5 * 33]); o.w = pk2(s[6 * 33], s[7 * 33]);
        *(u32x4*)(WT + (size_t)(nrow0 + n) * K + k0 + 8 * c) = o; }
    LDS_WAIT();
}

__device__ __forceinline__ void conv_fold_tile(const Ctx& C, const float* win, bf16* WIN, int tile, const float* gk) {
    LAS float* wt = (LAS float*)C.lds;
    LAS f32x2* tab = (LAS f32x2*)(C.lds + 33280);
    const int kb = tile >> 2, g = tile & 3, k0 = kb * 64;
    __syncthreads();
    for (int e = C.tid; e < 64 * 128; e += 512) { const int kk = e >> 7, c = e & 127; wt[kk * 129 + c] = win[(size_t)(k0 + kk) * 12288 + g * 128 + c] * gk[k0 + kk]; }
    if (C.tid < 128) { const float s = 0.08838834764831845f; tab[C.tid] = (f32x2){cospif((float)C.tid * (1.0f / 64.0f)) * s, sinpif((float)C.tid * (1.0f / 64.0f)) * s}; }
    __syncthreads();
    const int k = C.lane, jb = 16 * C.wave;
    float aP[16], aQ[16];
#pragma unroll
    for (int j = 0; j < 16; ++j) { aP[j] = 0.f; aQ[j] = 0.f; }
    for (int c = 0; c < 128; ++c) {
        const float w = wt[k * 129 + c];
#pragma unroll
        for (int j = 0; j < 16; ++j) { const f32x2 t = tab[(c * (jb + j)) & 127]; aP[j] += w * t.x; aQ[j] += w * t.y; }
    }
#pragma unroll
    for (int j = 0; j < 16; ++j) {
        int fo = jb + j; asm volatile("" : "+v"(fo));
        if (fo <= 64) WIN[(size_t)(128 * g + fo) * D + k0 + k] = (bf16)(pk2(aP[j], 0.f) & 0xffffu);
        if (fo >= 1 && fo <= 63) WIN[(size_t)(128 * g + 64 + fo) * D + k0 + k] = (bf16)(pk2(aQ[j], 0.f) & 0xffffu);
    }
}
__device__ __forceinline__ void phase_wconv(const Ctx& C, const ArgsK& a, int l, int groups, int rank, int count) {
    if (rank < 0) return;
    unsigned char* ws = a.ws;
    const float* w1i = a.in[3] + (size_t)l * D * 2 * FF;  const float* w1d = a.in[4] + (size_t)l * FF * D;
    const float* win = a.in[6] + (size_t)l * D * 12288;   const float* wfo = a.in[9] + (size_t)l * FW * D;
    const float* who = a.in[10] + (size_t)l * HG * D;     const float* wou = a.in[11] + (size_t)l * D * D;
    const float* w2i = a.in[13] + (size_t)l * D * 2 * FF; const float* w2d = a.in[14] + (size_t)l * FF * D;
    for (int tile = rank; tile < ((groups & 1) ? 128 : 0); tile += count) conv_fold_tile(C, win, (bf16*)(ws + WS_WIN), tile, a.in[5] + (size_t)l * D);
    __syncthreads();
    LAS float* scr = (LAS float*)(C.lds + C.wave * 16384);
    constexpr int I_WI = 32 * 344, I_WD = 86 * 64, I_IN = 32 * 368, I_FO = 8 * 64, I_HO = 24 * 64, I_OU = 32 * 64;
    constexpr int NIT = 2 * I_WI + 2 * I_WD + I_IN + I_FO + I_HO + I_OU;
    for (int it = rank * 8 + C.wave; it < NIT; it += count * 8) {
        int r = it;
        { const bool g1 = (r < I_WI) || (r >= 2 * I_WI && r < 2 * I_WI + I_WD) || (r >= 2 * I_WI + 2 * I_WD && r < 2 * I_WI + 2 * I_WD + I_IN); if (!((g1 ? 1 : 2) & groups)) continue; }
        if (r < 2 * I_WI) { const bool second = r >= I_WI; if (second) r -= I_WI;
            const int kb = r / 344, nb = r % 344, n0 = 32 * nb, p = n0 >> 8, j = n0 & 255;
            const int sc = j < 128 ? 128 * p + j : FF + 128 * p + (j - 128);
            conv_item(second ? w2i : w1i, D, 2 * FF, sc, (bf16*)(ws + (second ? WS_W2I : WS_W1I)), n0, 64 * kb, scr, C.lane, a.in[second ? 12 : 2] + (size_t)l * D); continue; }
        r -= 2 * I_WI;
        if (r < 2 * I_WD) { const bool second = r >= I_WD; if (second) r -= I_WD;
            const int kb = r / 64, nb = r % 64;
            conv_item(second ? w2d : w1d, FF, D, 32 * nb, (bf16*)(ws + (second ? WS_W2D : WS_W1D)), 32 * nb, 64 * kb, scr, C.lane); continue; }
        r -= 2 * I_WD;
        if (r < I_IN) { const int kb = r / 368, nb = r % 368; conv_item(win, D, 12288, 512 + 32 * nb, (bf16*)(ws + WS_WIN), 512 + 32 * nb, 64 * kb, scr, C.lane, a.in[5] + (size_t)l * D); continue; }
        r -= I_IN;
        if (r < I_FO) { const int kb = r / 64, nb = r % 64; conv_item(wfo, FW, D, 32 * nb, (bf16*)(ws + WS_WFO), 32 * nb, 64 * kb, scr, C.lane); continue; }
        r -= I_FO;
        if (r < I_HO) { const int kb = r / 64, nb = r % 64; conv_item(who, HG, D, 32 * nb, (bf16*)(ws + WS_WHO), 32 * nb, 64 * kb, scr, C.lane); continue; }
        r -= I_HO;
        { const int kb = r / 64, nb = r % 64; conv_item(wou, D, D, 32 * nb, (bf16*)(ws + WS_WOU), 32 * nb, 64 * kb, scr, C.lane); }
    }
}

constexpr int Q_WI = 32 * 344, Q_WD = 86 * 64, Q_IN = 32 * 368, Q_NIT = Q_WI + Q_WD + Q_IN, CONV_NCH = 128 + (Q_NIT + 127) / 128;
__device__ __forceinline__ void conv_chunk(const Ctx& C, const ArgsK& a, int l, int c) {
    unsigned char* ws = a.ws;
    const float* win = a.in[6] + (size_t)l * D * 12288;
    if (c < 128) { conv_fold_tile(C, win, (bf16*)(ws + WS_WIN), c, a.in[5] + (size_t)l * D); return; }
    const float* w1i = a.in[3] + (size_t)l * D * 2 * FF;  const float* w1d = a.in[4] + (size_t)l * FF * D;
    LAS float* scr = (LAS float*)(C.lds + C.wave * 16384);
    const int base = (c - 128) * 128, end = base + 128 < Q_NIT ? base + 128 : Q_NIT;
    for (int r0 = base + C.wave; r0 < end; r0 += 8) { int r = r0;
        if (r < Q_WI) { const int kb = r / 344, nb = r % 344, n0 = 32 * nb, p = n0 >> 8, j = n0 & 255; const int sc = j < 128 ? 128 * p + j : FF + 128 * p + (j - 128);
            conv_item(w1i, D, 2 * FF, sc, (bf16*)(ws + WS_W1I), n0, 64 * kb, scr, C.lane, a.in[2] + (size_t)l * D); continue; }
        r -= Q_WI;
        if (r < Q_WD) { const int kb = r / 64, nb = r % 64; conv_item(w1d, FF, D, 32 * nb, (bf16*)(ws + WS_W1D), 32 * nb, 64 * kb, scr, C.lane); continue; }
        r -= Q_WD;
        { const int kb = r / 368, nb = r % 368; conv_item(win, D, 12288, 512 + 32 * nb, (bf16*)(ws + WS_WIN), 512 + 32 * nb, 64 * kb, scr, C.lane, a.in[5] + (size_t)l * D); }
    }
}
__device__ __forceinline__ int wq_grab(const Ctx& C, unsigned* ctr, unsigned* stopw, unsigned stop_at) {
    volatile LAS int* slot = (volatile LAS int*)(C.lds + LDS_BAR_OFF + 32);
    __syncthreads();
    if (C.tid == 0) { int v = -1;
        if (!(stop_at && __hip_atomic_load(stopw, __ATOMIC_RELAXED, __HIP_MEMORY_SCOPE_AGENT) >= stop_at)) v = (int)__hip_atomic_fetch_add(ctr, 1u, __ATOMIC_RELAXED, __HIP_MEMORY_SCOPE_AGENT);
        *slot = v; }
    __syncthreads();
    return __builtin_amdgcn_readfirstlane(*slot);
}
constexpr int Q2_FO = 8 * 64, Q2_HO = 24 * 64, Q2_OU = 32 * 64, CONV2_NCH = (Q_WI + Q_WD + Q2_FO + Q2_HO + Q2_OU) / 128;
static_assert((Q_WI % 128) == 0 && (Q_WD % 128) == 0 && (Q2_FO % 128) == 0 && (Q2_HO % 128) == 0 && (Q2_OU % 128) == 0, "chunks never straddle two weights");
__device__ __forceinline__ void conv_chunk2(const Ctx& C, const ArgsK& a, int l, int c) {
    unsigned char* ws = a.ws;
    LAS float* scr = (LAS float*)(C.lds + C.wave * 16384);
    for (int r0 = c * 128 + C.wave; r0 < (c + 1) * 128; r0 += 8) { int r = r0;
        if (r < Q_WI) { const int kb = r / 344, nb = r % 344, n0 = 32 * nb, p = n0 >> 8, j = n0 & 255; const int sc = j < 128 ? 128 * p + j : FF + 128 * p + (j - 128);
            conv_item(a.in[13] + (size_t)l * D * 2 * FF, D, 2 * FF, sc, (bf16*)(ws + WS_W2I), n0, 64 * kb, scr, C.lane, a.in[12] + (size_t)l * D); continue; }
        r -= Q_WI;
        if (r < Q_WD) { const int kb = r / 64, nb = r % 64; conv_item(a.in[14] + (size_t)l * FF * D, FF, D, 32 * nb, (bf16*)(ws + WS_W2D), 32 * nb, 64 * kb, scr, C.lane); continue; }
        r -= Q_WD;
        if (r < Q2_FO) { const int kb = r / 64, nb = r % 64; conv_item(a.in[9] + (size_t)l * FW * D, FW, D, 32 * nb, (bf16*)(ws + WS_WFO), 32 * nb, 64 * kb, scr, C.lane); continue; }
        r -= Q2_FO;
        if (r < Q2_HO) { const int kb = r / 64, nb = r % 64; conv_item(a.in[10] + (size_t)l * HG * D, HG, D, 32 * nb, (bf16*)(ws + WS_WHO), 32 * nb, 64 * kb, scr, C.lane); continue; }
        r -= Q2_HO;
        { const int kb = r / 64, nb = r % 64; conv_item(a.in[11] + (size_t)l * D * D, D, D, 32 * nb, (bf16*)(ws + WS_WOU), 32 * nb, 64 * kb, scr, C.lane); }
    }
}

__device__ __forceinline__ void phase_prologue(const Ctx& C, const ArgsK& a) {
    const int gt = C.vcu * 512 + C.tid, NT = C.G * 512;
    float* lb = (float*)(a.ws + WS_LB); const float* lg = a.in[7];
    for (int i = gt; i < 2 * HG; i += NT) {
        const int d = i / HG, c = i % HG; float z[4], mx = -3.0e38f;
#pragma unroll
        for (int l = 0; l < 4; ++l) { z[l] = lg[(size_t)(d * 4 + l) * HG + c]; mx = fmaxf(mx, z[l]); }
        float s = 0.f;
#pragma unroll
        for (int l = 0; l < 4; ++l) { z[l] = expf(z[l] - mx); s += z[l]; }
        const float p0 = z[0] / s; float cum = 0.f;
#pragma unroll
        for (int l = 0; l < 4; ++l) { cum += z[l] / s; lb[(size_t)(d * 4 + l) * HG + c] = fmaxf(cum - p0, 0.f); }
    }
    bf16* D8 = (bf16*)(a.ws + WS_DM8);
    for (size_t i = gt; i < (size_t)4096 * 8192 / 8; i += NT) {
        const int k = (int)(i >> 10), n0 = (int)(i & 1023) * 8; float c[8], sn[8];
#pragma unroll
        for (int j = 0; j < 8; ++j) { const int m = (k * (n0 + j)) & 8191; sincospif((float)m * (1.0f / 4096.0f), &sn[j], &c[j]); }
        u32x4 o; o.x = pk2(c[0], c[1]); o.y = pk2(c[2], c[3]); o.z = pk2(c[4], c[5]); o.w = pk2(c[6], c[7]);
        *(u32x4*)(D8 + i * 8) = o;
        o.x = pk2(-sn[0], -sn[1]); o.y = pk2(-sn[2], -sn[3]); o.z = pk2(-sn[4], -sn[5]); o.w = pk2(-sn[6], -sn[7]);
        *(u32x4*)(D8 + (size_t)4096 * 8192 + i * 8) = o;
    }
    bf16* D2 = (bf16*)(a.ws + WS_DM2);
    for (size_t i = gt; i < (size_t)1024 * 2048 / 8; i += NT) {
        const int k = (int)(i >> 8), n0 = (int)(i & 255) * 8; float c[8], sn[8];
#pragma unroll
        for (int j = 0; j < 8; ++j) { const int m = (k * (n0 + j)) & 2047; sincospif((float)m * (1.0f / 1024.0f), &sn[j], &c[j]); }
        u32x4 o; o.x = pk2(c[0], c[1]); o.y = pk2(c[2], c[3]); o.z = pk2(c[4], c[5]); o.w = pk2(c[6], c[7]);
        *(u32x4*)(D2 + i * 8) = o;
        o.x = pk2(-sn[0], -sn[1]); o.y = pk2(-sn[2], -sn[3]); o.z = pk2(-sn[4], -sn[5]); o.w = pk2(-sn[6], -sn[7]);
        *(u32x4*)(D2 + (size_t)1024 * 2048 + i * 8) = o;
    }
}

__device__ __forceinline__ void phase_norm(const Ctx& C, const float* xp, const float* xs, const float* gain, bf16* U) {
    f32x4 g[8];
#pragma unroll
    for (int j = 0; j < 8; ++j) g[j] = ((const f32x4*)gain)[C.lane + 64 * j];
    for (int m = C.gw; m < T; m += C.NGW) {
        const f32x4* xr = (const f32x4*)(m < TP ? xp + (size_t)m * D : xs + (size_t)(m - TP) * D) + C.lane;
        f32x4 v[8]; float s = 0.f;
#pragma unroll
        for (int j = 0; j < 8; ++j) { v[j] = xr[64 * j]; s += (v[j].x * v[j].x + v[j].y * v[j].y) + (v[j].z * v[j].z + v[j].w * v[j].w); }
        const float r = 1.0f / sqrtf(wave_sum(s, C.lane) * (1.0f / D) + EPS);
        u32x2* o = (u32x2*)(U + (size_t)m * D) + C.lane;
#pragma unroll
        for (int j = 0; j < 8; ++j) { u32x2 w; w.x = pk2(v[j].x * r * g[j].x, v[j].y * r * g[j].y); w.y = pk2(v[j].z * r * g[j].z, v[j].w * r * g[j].w); o[64 * j] = w; }
    }
}
__device__ __forceinline__ void phase_cast0(const Ctx& C, const float* xp, const float* xs, bf16* U, float* rs) {
    for (int m = C.gw; m < T; m += C.NGW) {
        const f32x4* xr = (const f32x4*)(m < TP ? xp + (size_t)m * D : xs + (size_t)(m - TP) * D) + C.lane;
        f32x4 v[8]; float s = 0.f;
#pragma unroll
        for (int j = 0; j < 8; ++j) { v[j] = xr[64 * j]; s += (v[j].x * v[j].x + v[j].y * v[j].y) + (v[j].z * v[j].z + v[j].w * v[j].w); }
        s = wave_sum(s, C.lane);
        u32x2* o = (u32x2*)(U + (size_t)m * D) + C.lane;
#pragma unroll
        for (int j = 0; j < 8; ++j) { u32x2 w; w.x = pk2(v[j].x, v[j].y); w.y = pk2(v[j].z, v[j].w); o[64 * j] = w; }
        if (C.lane < 32) rs[(size_t)m * 32 + C.lane] = C.lane == 0 ? s : 0.f;
    }
}
template <bool OUT_F32>
__device__ __forceinline__ void phase_norm16(const Ctx& C, const bf16* x16, const float* gain, bf16* U, float* out) {
    f32x4 g[8];
#pragma unroll
    for (int j = 0; j < 4; ++j) { g[2 * j] = ((const f32x4*)gain)[2 * (C.lane + 64 * j)]; g[2 * j + 1] = ((const f32x4*)gain)[2 * (C.lane + 64 * j) + 1]; }
    for (int m = C.gw; m < T; m += C.NGW) {
        const u32x4* xr = (const u32x4*)(x16 + (size_t)m * D) + C.lane;
        u32x4 pv[4]; f32x4 v[8]; float s = 0.f;
#pragma unroll
        for (int j = 0; j < 4; ++j) pv[j] = xr[64 * j];
#pragma unroll
        for (int j = 0; j < 4; ++j) {
            v[2 * j] = (f32x4){__uint_as_float(pv[j].x << 16), __uint_as_float(pv[j].x & 0xffff0000u), __uint_as_float(pv[j].y << 16), __uint_as_float(pv[j].y & 0xffff0000u)};
            v[2 * j + 1] = (f32x4){__uint_as_float(pv[j].z << 16), __uint_as_float(pv[j].z & 0xffff0000u), __uint_as_float(pv[j].w << 16), __uint_as_float(pv[j].w & 0xffff0000u)}; }
#pragma unroll
        for (int j = 0; j < 8; ++j) s += (v[j].x * v[j].x + v[j].y * v[j].y) + (v[j].z * v[j].z + v[j].w * v[j].w);
        const float r = 1.0f / sqrtf(wave_sum(s, C.lane) * (1.0f / D) + EPS);
        if constexpr (OUT_F32) { f32x4* o = (f32x4*)(out + (size_t)m * D) + 2 * C.lane;
#pragma unroll
            for (int j = 0; j < 4; ++j) { o[128 * j] = v[2 * j] * r * g[2 * j]; o[128 * j + 1] = v[2 * j + 1] * r * g[2 * j + 1]; }
        } else { u32x4* o = (u32x4*)(U + (size_t)m * D) + C.lane;
#pragma unroll
            for (int j = 0; j < 4; ++j) { const f32x4 a0 = v[2 * j] * r * g[2 * j], a1 = v[2 * j + 1] * r * g[2 * j + 1];
                u32x4 w; w.x = pk2(a0.x, a0.y); w.y = pk2(a0.z, a0.w); w.z = pk2(a1.x, a1.y); w.w = pk2(a1.z, a1.w); o[64 * j] = w; } }
    }
}


typedef float f32x16 __attribute__((ext_vector_type(16)));
__device__ __forceinline__ void scan_item(const Ctx& C, const float* LFd, const bf16* QS, const bf16* VV, bf16* Oraw, int start, int len, int head, int dir, int mode, float* Ebuf, float* Lbuf, int lseg) {
    constexpr int PQ = 272, PK = 144;
    LAS unsigned char* const lds = C.lds;
    LAS unsigned char* const QD = lds, * const KD = lds + 17408, * const KDT = lds + 34816, * const VT = lds + 53248, * const PP_ = lds + 71680, * const SRT = lds + 80896;
    LAS float* const sO = (LAS float*)lds;
    LAS float* const sT = (LAS float*)(lds + 115712); LAS float* const sR = sT + 512; LAS float* const sB63 = sR + 128; LAS float* const sD = sB63 + 128; LAS float* const sE = sD + 128; LAS float* const sER = sE + 128;
    const int w = C.wave, p = w >> 1;
    asm volatile("s_waitcnt vmcnt(0)" ::: "memory"); __syncthreads();
    f32x16 S0, S1;
#pragma unroll
    for (int i = 0; i < 16; ++i) { S0[i] = 0.f; S1[i] = 0.f; }
    if (mode == 2 && lseg > 0) {
        const int ln = C.lane, hh = ln >> 5, vt = w & 3;
        int nseg = lseg; asm volatile("" : "+s"(nseg));
        for (int js = 0; js < nseg; ++js) {
            const float* Ej = Ebuf + (size_t)js * 16384; const float* Lj = Lbuf + js * 128;
            float lv[2][16], ev[2][16];
#pragma unroll
            for (int j = 0; j < 2; ++j) { const int kt = 2 * (w >> 2) + j;
#pragma unroll
                for (int i = 0; i < 16; ++i) lv[j][i] = __hip_atomic_load(Lj + 32 * kt + (i & 3) + 8 * (i >> 2) + 4 * hh, __ATOMIC_RELAXED, __HIP_MEMORY_SCOPE_AGENT); }
#pragma unroll
            for (int j = 0; j < 2; ++j) { const int kt = 2 * (w >> 2) + j; const float* tp = Ej + ((kt * 4 + vt) * 16) * 64 + ln;
#pragma unroll
                for (int i = 0; i < 16; ++i) ev[j][i] = __hip_atomic_load(tp + i * 64, __ATOMIC_RELAXED, __HIP_MEMORY_SCOPE_AGENT); }
#pragma unroll
            for (int i = 0; i < 16; ++i) { S0[i] = __expf(lv[0][i]) * S0[i] + ev[0][i]; S1[i] = __expf(lv[1][i]) * S1[i] + ev[1][i]; }
        }
    }
    float lsum = 0.f;
    const long st_ = dir == 0 ? (long)HG : -(long)HG;
    const int nch = len / 64;
    float nlf[16]; unsigned nv[8];
#define SCAN_LOAD(cc) do { const int tk0 = dir == 0 ? start + 64 * (cc) : start + len - 64 - 64 * (cc); \
        const size_t idx0 = (size_t)(dir == 0 ? tk0 + 16 * p : tk0 + 63 - 16 * p) * HG + head * 128 + k; const float* lp = LFd + idx0; const bf16* vp = VV + idx0; \
        _Pragma("unroll") for (int i = 0; i < 16; ++i) { nlf[i] = *lp; lp += st_; } \
        _Pragma("unroll") for (int i = 0; i < 8; ++i) { nv[i] = (unsigned)vp[0] | ((unsigned)vp[st_] << 16); vp += 2 * st_; } } while (0)
    int lane = C.lane, k = (w & 1) * 64 + lane, h = lane >> 5, l31 = lane & 31;
    SCAN_LOAD(0);
    for (int c = 0; c < nch; ++c) {
        { int l_ = C.lane; asm volatile("" : "+v"(l_)); lane = l_; k = (w & 1) * 64 + lane; h = lane >> 5; l31 = lane & 31; }
        const int tok0 = dir == 0 ? start + 64 * c : start + len - 64 - 64 * c;
        float bl[16]; float bs = 0.f; unsigned nq[8];
#pragma unroll
        for (int i = 0; i < 8; ++i) nq[i] = 0u;
        if (mode != 1) { const bf16* qp = QS + (size_t)(dir == 0 ? tok0 + 16 * p : tok0 + 63 - 16 * p) * HG + head * 128 + k;
#pragma unroll
          for (int i = 0; i < 8; ++i) { nq[i] = (unsigned)qp[0] | ((unsigned)qp[st_] << 16); qp += 2 * st_; } }
        { u32x4 v0, v1; v0.x = nv[0]; v0.y = nv[1]; v0.z = nv[2]; v0.w = nv[3]; v1.x = nv[4]; v1.y = nv[5]; v1.z = nv[6]; v1.w = nv[7];
          *(LAS u32x4*)(VT + k * PK + 32 * p) = v0; *(LAS u32x4*)(VT + k * PK + 32 * p + 16) = v1; }
#pragma unroll
        for (int i = 0; i < 16; ++i) { bs += nlf[i]; bl[i] = bs; nlf[i] = 1.0f - __expf(nlf[i]); }
        sT[p * 128 + k] = bs;
        __syncthreads();
        { float off = 0.f;
#pragma unroll
          for (int pp = 0; pp < 3; ++pp) off += pp < p ? sT[pp * 128 + k] : 0.f;
#pragma unroll
          for (int i = 0; i < 16; ++i) bl[i] += off; }
        if (p == 1) { sR[k] = bl[15]; sER[k] = __expf(bl[15]); }
        if (p == 3) { sB63[k] = bl[15]; lsum += bl[15]; }
        __syncthreads();
        { const float r = sR[k], b63 = sB63[k];
          if (p == 0) { sD[k] = __expf(b63); sE[k] = __expf(b63 - r); }
          unsigned kw[8];
#pragma unroll
          for (int i = 0; i < 16; ++i) { const int li = 16 * p + i; const float kkv = nlf[i], qvi = (i & 1) ? __uint_as_float(nq[i >> 1] & 0xffff0000u) : __uint_as_float(nq[i >> 1] << 16);
              float qdv = 0.f; if (mode != 1) qdv = qvi * __expf(fminf(bl[i] - r, 80.f));
              const float kdv = kkv * __expf(fminf(r - bl[i], 80.f));
              const unsigned pq_ = pk2(qdv, kdv);
              if (mode != 1) { *(LAS unsigned short*)(QD + li * PQ + 2 * k) = (unsigned short)(pq_ & 0xffffu); *(LAS unsigned short*)(KD + li * PQ + 2 * k) = (unsigned short)(pq_ >> 16); }
              if (i & 1) kw[i >> 1] |= pq_ & 0xffff0000u; else kw[i >> 1] = pq_ >> 16; }
          u32x4 v0, v1; v0.x = kw[0]; v0.y = kw[1]; v0.z = kw[2]; v0.w = kw[3]; v1.x = kw[4]; v1.y = kw[5]; v1.z = kw[6]; v1.w = kw[7];
          *(LAS u32x4*)(KDT + k * PK + 32 * p) = v0; *(LAS u32x4*)(KDT + k * PK + 32 * p + 16) = v1; }
        if (mode != 1) { const int vt = w & 3, vrow = 32 * vt + l31;
#pragma unroll
          for (int j = 0; j < 2; ++j) { const int kt = 2 * (w >> 2) + j;
#pragma unroll
            for (int g = 0; g < 4; ++g) { const int k0 = 32 * kt + 8 * g + 4 * h; const f32x4 er = *(const LAS f32x4*)(sER + k0);
                const float a0 = (j ? S1[4 * g + 0] : S0[4 * g + 0]) * er[0], a1 = (j ? S1[4 * g + 1] : S0[4 * g + 1]) * er[1], a2 = (j ? S1[4 * g + 2] : S0[4 * g + 2]) * er[2], a3 = (j ? S1[4 * g + 3] : S0[4 * g + 3]) * er[3];
                u32x2 o_; o_.x = pk2(a0, a1); o_.y = pk2(a2, a3); *(LAS u32x2*)(SRT + vrow * PQ + 2 * k0) = o_; } } }
        __syncthreads();
        SCAN_LOAD(c + 1 < nch ? c + 1 : c);
        if (w < 4 && mode != 1) { const int tt = w >> 1, st = w & 1; f32x16 pa;
#pragma unroll
            for (int i = 0; i < 16; ++i) pa[i] = 0.f;
            if (tt >= st) {
#pragma unroll 2
                for (int ks = 0; ks < 8; ++ks) { const bf16x8 a = *(const LAS bf16x8*)(QD + (32 * tt + l31) * PQ + 32 * ks + 16 * h), b = *(const LAS bf16x8*)(KD + (32 * st + l31) * PQ + 32 * ks + 16 * h);
                    pa = __builtin_amdgcn_mfma_f32_32x32x16_bf16(a, b, pa, 0, 0, 0); } }
#pragma unroll
            for (int i = 0; i < 16; ++i) { const int tl = 32 * tt + (i & 3) + 8 * (i >> 2) + 4 * h, sl = 32 * st + l31; const float v_ = sl <= tl ? pa[i] : 0.f;
                *(LAS unsigned short*)(PP_ + tl * PK + 2 * sl) = (unsigned short)(pk2(v_, 0.f) & 0xffffu); } }
        f32x16 oa;
#pragma unroll
        for (int i = 0; i < 16; ++i) oa[i] = 0.f;
        if (mode != 1) { const int tt = w >> 2, vt = w & 3;
#pragma unroll 2
          for (int ks = 0; ks < 8; ++ks) { const bf16x8 a = *(const LAS bf16x8*)(QD + (32 * tt + l31) * PQ + 32 * ks + 16 * h), b = *(const LAS bf16x8*)(SRT + (32 * vt + l31) * PQ + 32 * ks + 16 * h);
              oa = __builtin_amdgcn_mfma_f32_32x32x16_bf16(a, b, oa, 0, 0, 0); } }
        { const int vt = w & 3;
#pragma unroll
          for (int j = 0; j < 2; ++j) { const int kt = 2 * (w >> 2) + j; f32x16 wa;
#pragma unroll
            for (int i = 0; i < 16; ++i) wa[i] = 0.f;
#pragma unroll 2
            for (int ks = 0; ks < 4; ++ks) { const bf16x8 a = *(const LAS bf16x8*)(KDT + (32 * kt + l31) * PK + 32 * ks + 16 * h), b = *(const LAS bf16x8*)(VT + (32 * vt + l31) * PK + 32 * ks + 16 * h);
                wa = __builtin_amdgcn_mfma_f32_32x32x16_bf16(a, b, wa, 0, 0, 0); }
#pragma unroll
            for (int g = 0; g < 4; ++g) { const int k0 = 32 * kt + 8 * g + 4 * h; const f32x4 dd = *(const LAS f32x4*)(sD + k0), ee = *(const LAS f32x4*)(sE + k0);
#pragma unroll
                for (int q_ = 0; q_ < 4; ++q_) { if (j) S1[4 * g + q_] = dd[q_] * S1[4 * g + q_] + ee[q_] * wa[4 * g + q_]; else S0[4 * g + q_] = dd[q_] * S0[4 * g + q_] + ee[q_] * wa[4 * g + q_]; } } } }
        __syncthreads();
        if (mode != 1) { const int tt = w >> 2, vt = w & 3;
#pragma unroll 2
          for (int ks = 0; ks < 4; ++ks) { const bf16x8 a = *(const LAS bf16x8*)(PP_ + (32 * tt + l31) * PK + 32 * ks + 16 * h), b = *(const LAS bf16x8*)(VT + (32 * vt + l31) * PK + 32 * ks + 16 * h);
              oa = __builtin_amdgcn_mfma_f32_32x32x16_bf16(a, b, oa, 0, 0, 0); }
#pragma unroll
          for (int i = 0; i < 16; ++i) { const int li = 32 * tt + (i & 3) + 8 * (i >> 2) + 4 * h, g = dir == 0 ? tok0 + li : tok0 + 63 - li;
              Oraw[(size_t)g * HG + head * 128 + 32 * vt + l31] = (bf16)(pk2(oa[i], 0.f) & 0xffffu); } }
        if (mode != 1) __syncthreads();
    }
#undef SCAN_LOAD
    if (mode == 1) {
        const int ln = C.lane, vt = w & 3; float* Ej = Ebuf + (size_t)lseg * 16384;
#pragma unroll
        for (int j = 0; j < 2; ++j) { const int kt = 2 * (w >> 2) + j; float* tp = Ej + ((kt * 4 + vt) * 16) * 64 + ln;
#pragma unroll
            for (int i = 0; i < 16; ++i) __hip_atomic_store(tp + i * 64, j ? S1[i] : S0[i], __ATOMIC_RELAXED, __HIP_MEMORY_SCOPE_AGENT); }
        if (p == 3) __hip_atomic_store(Lbuf + lseg * 128 + (w & 1) * 64 + ln, lsum, __ATOMIC_RELAXED, __HIP_MEMORY_SCOPE_AGENT);
    }
    __syncthreads();
}
__device__ __forceinline__ void scan_chain(const Ctx& C, const float* LF, const bf16* QS, const bf16* VV, bf16* OF, bf16* OB, float* EB, float* LS, int ch, int lseg, int mode) {
    const int sq = ch / 24, rem = ch % 24, head = rem >> 1, dir = rem & 1, s0 = TP + sq * 8192;
    scan_item(C, LF + (size_t)dir * T * HG, QS, VV, dir ? OB : OF, dir == 0 ? s0 + 2048 * lseg : s0 + 8192 - 2048 * (lseg + 1), 2048, head, dir, mode, EB + (size_t)ch * 3 * 16384, LS + ch * 3 * 128, lseg);
}
__device__ __forceinline__ void scan_short(const Ctx& C, const float* LF, const bf16* QS, const bf16* VV, bf16* OF, bf16* OB, float* EB, float* LS, int pi) {
    const int seq = pi / 24, rem = pi % 24, head = rem >> 1, dir = rem & 1;
    scan_item(C, LF + (size_t)dir * T * HG, QS, VV, dir ? OB : OF, seq * 2048, 2048, head, dir, 0, EB, LS, 0);
}
__device__ __forceinline__ void phase_scan_a(const Ctx& C, const float* LF, const bf16* QS, const bf16* VV, bf16* OF, bf16* OB, float* EB, float* LS) {
    const int j = (int)blockIdx.x - (C.G - 128);
    if (j < 0) return;
    if (j < 32) { scan_short(C, LF, QS, VV, OF, OB, EB, LS, j); return; }
    const int ia = j < 80 ? 2 * (j - 32) : 96 + (j - 80), na = j < 80 ? 2 : 1;
    for (int i = 0; i < na; ++i) scan_chain(C, LF, QS, VV, OF, OB, EB, LS, (ia + i) / 3, (ia + i) % 3, 1);
}
__device__ __forceinline__ void phase_scan_b(const Ctx& C, const float* LF, const bf16* QS, const bf16* VV, bf16* OF, bf16* OB, float* EB, float* LS) {
    const int it = (int)blockIdx.x;
    if (it < 192) scan_chain(C, LF, QS, VV, OF, OB, EB, LS, it >> 2, it & 3, (it & 3) ? 2 : 0);
    else if (it < 256) scan_short(C, LF, QS, VV, OF, OB, EB, LS, 32 + (it - 192));
}
__device__ __forceinline__ void phase_dft_combine(const Ctx& C, unsigned char* ws, int rank, int count) {
    if (rank < 0) return;
    const float* A0 = (const float*)(ws + WS_U); const float* A1 = A0 + (size_t)(T / 2) * FW; bf16* Y = (bf16*)(ws + WS_YY);
    constexpr int TOTAL = (T / 2) * (FW / 4);
    const int stride = count * 512;
    for (int i0 = rank * 512 + C.tid; i0 < TOTAL; i0 += 4 * stride) {
        f32x4 a_[4], b_[4];
#pragma unroll
        for (int u = 0; u < 4; ++u) { const int i = i0 + u * stride < TOTAL ? i0 + u * stride : i0; const int r = i >> 7, c4 = (i & 127) * 4;
            a_[u] = *(const f32x4*)(A0 + (size_t)r * FW + c4); b_[u] = *(const f32x4*)(A1 + (size_t)r * FW + c4); }
#pragma unroll
        for (int u = 0; u < 4; ++u) { const int i = i0 + u * stride; if (i < TOTAL) { const int r = i >> 7, c4 = (i & 127) * 4; int t0, S, n;
            if (r < TP / 2) { const int sq = r >> 10; n = r & 1023; t0 = sq * 2048; S = 2048; } else { const int r2 = r - TP / 2, sq = r2 >> 12; n = r2 & 4095; t0 = TP + sq * 8192; S = 8192; }
            u32x2 o; o.x = pk2(a_[u][0] + b_[u][0], a_[u][1] + b_[u][1]); o.y = pk2(a_[u][2] + b_[u][2], a_[u][3] + b_[u][3]); *(u32x2*)(Y + (size_t)(t0 + n) * FW + c4) = o;
            if (n) { o.x = pk2(a_[u][0] - b_[u][0], a_[u][1] - b_[u][1]); o.y = pk2(a_[u][2] - b_[u][2], a_[u][3] - b_[u][3]); *(u32x2*)(Y + (size_t)(t0 + S - n) * FW + c4) = o; } } }
    }
    const bf16* PQT = (const bf16*)(ws + WS_PQT);
    for (int task = rank * 8 + C.wave; task < 6 * 512; task += count * 8) {
        const int sq = task >> 9, c = task & 511; int t0, S; const bf16* p;
        if (sq < 4) { S = 2048; t0 = sq * 2048; p = PQT + (size_t)sq * 512 * 4096 + (size_t)c * 2048; }
        else { S = 8192; t0 = TP + (sq - 4) * 8192; p = PQT + (size_t)4 * 512 * 4096 + (size_t)(sq - 4) * 512 * 16384 + (size_t)c * 8192; }
        float sm = 0.f;
        for (int m = C.lane * 8; m < S; m += 2048) { u32x4 v[4];
#pragma unroll
            for (int u = 0; u < 4; ++u) v[u] = *(const u32x4*)(p + m + 512 * u);
#pragma unroll
            for (int u = 0; u < 4; ++u) sm += ((__uint_as_float(v[u].x << 16) - __uint_as_float(v[u].x & 0xffff0000u)) + (__uint_as_float(v[u].y << 16) - __uint_as_float(v[u].y & 0xffff0000u)))
                + ((__uint_as_float(v[u].z << 16) - __uint_as_float(v[u].z & 0xffff0000u)) + (__uint_as_float(v[u].w << 16) - __uint_as_float(v[u].w & 0xffff0000u))); }
        sm = wave_sum(sm, C.lane);
        if (C.lane == 0) Y[(size_t)(t0 + S / 2) * FW + c] = (bf16)(pk2(sm * (S == 2048 ? 0.022097086912079612f : 0.011048543456039806f), 0.f) & 0xffffu);
    }
}
__device__ __forceinline__ void phase_scan_finalize(const Ctx& C, const bf16* OF, const bf16* OB, const bf16* GO, const float* hgain, bf16* OO) {
    f32x4 g[6];
#pragma unroll
    for (int j = 0; j < 6; ++j) g[j] = ((const f32x4*)hgain)[C.lane + 64 * j];
    for (int tok = C.gw; tok < T; tok += C.NGW) {
        const u32x2* pf = (const u32x2*)(OF + (size_t)tok * HG) + C.lane; const u32x2* pb = (const u32x2*)(OB + (size_t)tok * HG) + C.lane; const u32x2* pg = (const u32x2*)(GO + (size_t)tok * HG) + C.lane;
        f32x4 t[6]; u32x2 gg[6], fa[6], fb[6]; float ss[6];
#pragma unroll
        for (int j = 0; j < 6; ++j) { fa[j] = pf[64 * j]; fb[j] = pb[64 * j]; gg[j] = pg[64 * j]; }
#pragma unroll
        for (int j = 0; j < 6; ++j) { t[j] = (f32x4){__uint_as_float(fa[j].x << 16) + __uint_as_float(fb[j].x << 16), __uint_as_float(fa[j].x & 0xffff0000u) + __uint_as_float(fb[j].x & 0xffff0000u),
                                                       __uint_as_float(fa[j].y << 16) + __uint_as_float(fb[j].y << 16), __uint_as_float(fa[j].y & 0xffff0000u) + __uint_as_float(fb[j].y & 0xffff0000u)}; }
#pragma unroll
        for (int j = 0; j < 6; ++j) ss[j] = (t[j].x * t[j].x + t[j].y * t[j].y) + (t[j].z * t[j].z + t[j].w * t[j].w);
#pragma unroll
        for (int o = 1; o < 32; o <<= 1) {
#pragma unroll
            for (int j = 0; j < 6; ++j) ss[j] += __builtin_bit_cast(float, __builtin_amdgcn_ds_bpermute((C.lane ^ o) << 2, __builtin_bit_cast(int, ss[j])));
        }
        u32x2* po = (u32x2*)(OO + (size_t)tok * HG) + C.lane;
#pragma unroll
        for (int j = 0; j < 6; ++j) { const float rn = 1.0f / sqrtf(ss[j] * (1.0f / 128.0f) + EPS);
            u32x2 w; w.x = pk2(t[j].x * rn * g[j].x * __uint_as_float(gg[j].x << 16), t[j].y * rn * g[j].y * __uint_as_float(gg[j].x & 0xffff0000u));
            w.y = pk2(t[j].z * rn * g[j].z * __uint_as_float(gg[j].y << 16), t[j].w * rn * g[j].w * __uint_as_float(gg[j].y & 0xffff0000u)); po[64 * j] = w; }
    }
}
__device__ __forceinline__ void phase_scan_slow(const Ctx& C, const float* LF, const bf16* QS, const bf16* VV, const bf16* GO, const float* hgain, float* OF, bf16* OO) {
    LAS float* sF = (LAS float*)C.lds; LAS float* sK = sF + 2048; LAS float* sQ = sK + 2048; LAS float* sV = sQ + 2048; LAS float* sO = sV + 2048;
    const int tid = C.tid, lane = C.lane, wave = C.wave, v4 = tid & 31, k8 = tid >> 5;
    for (int item = (int)blockIdx.x; item < 72; item += C.G) {
        const int seq = item / 12, head = item % 12;
        const int start = seq < 4 ? seq * 2048 : TP + (seq - 4) * 8192, len = seq < 4 ? 2048 : 8192;
        for (int dir = 0; dir < 2; ++dir) {
            float S[8][4];
#pragma unroll
            for (int i = 0; i < 8; ++i)
#pragma unroll
                for (int j = 0; j < 4; ++j) S[i][j] = 0.f;
            const float* LFd = LF + (size_t)dir * T * HG;
            for (int blk = 0; blk < len / 16; ++blk) {
                const int tok0 = start + (dir == 0 ? blk * 16 : len - 16 - blk * 16);
                __syncthreads();
                for (int e = tid; e < 2048; e += 512) { const int tt = e >> 7, c = e & 127; const size_t gi = (size_t)(tok0 + tt) * HG + head * 128 + c;
                    const float f = __expf(LFd[gi]); sF[e] = f; sK[e] = 1.0f - f; sQ[e] = bf2f(QS[gi]); sV[e] = bf2f(VV[gi]); }
                __syncthreads();
                for (int j = 0; j < 16; ++j) {
                    const int tt = dir == 0 ? j : 15 - j;
                    const f32x4 f0 = *(const LAS f32x4*)(sF + tt * 128 + 8 * k8), f1 = *(const LAS f32x4*)(sF + tt * 128 + 8 * k8 + 4);
                    const f32x4 k0 = *(const LAS f32x4*)(sK + tt * 128 + 8 * k8), k1 = *(const LAS f32x4*)(sK + tt * 128 + 8 * k8 + 4);
                    const f32x4 q0 = *(const LAS f32x4*)(sQ + tt * 128 + 8 * k8), q1 = *(const LAS f32x4*)(sQ + tt * 128 + 8 * k8 + 4);
                    const f32x4 vv = *(const LAS f32x4*)(sV + tt * 128 + 4 * v4);
                    f32x4 o = {0.f, 0.f, 0.f, 0.f};
#pragma unroll
                    for (int i = 0; i < 8; ++i) { const float fi = i < 4 ? f0[i & 3] : f1[i & 3], ki = i < 4 ? k0[i & 3] : k1[i & 3], qi = i < 4 ? q0[i & 3] : q1[i & 3];
#pragma unroll
                        for (int c4 = 0; c4 < 4; ++c4) { S[i][c4] = S[i][c4] * fi + ki * vv[c4]; o[c4] += S[i][c4] * qi; } }
#pragma unroll
                    for (int c4 = 0; c4 < 4; ++c4) o[c4] += __shfl_xor(o[c4], 32);
                    if (lane < 32) *(LAS f32x4*)(sO + (wave * 16 + tt) * 128 + 4 * v4) = o;
                }
                __syncthreads();
#pragma unroll
                for (int h2 = 0; h2 < 2; ++h2) {
                    const int tt = wave + 8 * h2; float t0 = 0.f, t1 = 0.f;
#pragma unroll
                    for (int w = 0; w < 8; ++w) { t0 += sO[(w * 16 + tt) * 128 + lane]; t1 += sO[(w * 16 + tt) * 128 + lane + 64]; }
                    const size_t gi = (size_t)(tok0 + tt) * HG + head * 128;
                    if (dir == 0) { OF[gi + lane] = t0; OF[gi + lane + 64] = t1; }
                    else { t0 += OF[gi + lane]; t1 += OF[gi + lane + 64];
                        const float r = 1.0f / sqrtf(wave_sum(t0 * t0 + t1 * t1, C.lane) * (1.0f / 128.0f) + EPS);
                        const float o0 = t0 * r * hgain[head * 128 + lane] * bf2f(GO[gi + lane]), o1 = t1 * r * hgain[head * 128 + lane + 64] * bf2f(GO[gi + lane + 64]);
                        OO[gi + lane] = (bf16)(pk2(o0, 0.f) & 0xffffu); OO[gi + lane + 64] = (bf16)(pk2(o1, 0.f) & 0xffffu); }
                }
            }
        }
    }
}


#ifdef STAGE_CHECK
constexpr size_t WS_DIAG = WS_CTL + 65536;
__device__ __forceinline__ int chk_row(int i) { return i == 0 ? 3 : i == 1 ? 300 : i == 2 ? 5000 : i == 3 ? 8191 : i == 4 ? 8192 : i == 5 ? 12345 : i == 6 ? 20000 : 24575; }
__device__ __forceinline__ float block_sum(float v, LAS float* red, int tid) {
    v = wave_sum(v, tid & 63); __syncthreads(); if ((tid & 63) == 0) red[tid >> 6] = v; __syncthreads();
    float s = 0.f;
#pragma unroll
    for (int w = 0; w < 8; ++w) s += red[w];
    return s;
}
__device__ __forceinline__ float dot_bf(const bf16* a, const float* w, int K, size_t stride, LAS float* red, int tid) {
    float p = 0.f; for (int k = tid; k < K; k += 512) p += bf2f(a[k]) * w[(size_t)k * stride];
    return block_sum(p, red, tid);
}
__device__ __forceinline__ void diag_upd(float* diag, int stage, float got, float ref, int tid) {
    if (tid == 0) { float e = fabsf(got - ref) / (fabsf(ref) + 0.3f); if (!(e == e)) e = 1e9f; if (e > diag[stage]) diag[stage] = e; }
}
__device__ __forceinline__ void stage_check(int site, int l, unsigned char* ws, const ArgsK& a, LAS unsigned char* lds_, int tid) {
    LAS float* red = (LAS float*)(lds_ + 120000);
    float* diag = (float*)(ws + WS_DIAG);
    const bf16* U = (const bf16*)(ws + WS_U); const float* X = a.out;
    for (int ri = 0; ri < 8; ++ri) {
        const int r = chk_row(ri);
        const float* xin = r < TP ? a.in[0] + (size_t)r * D : a.in[1] + (size_t)(r - TP) * D;
        if (site == 1 || site == 4 || site == 11) {
            const float* xr = (site == 1 && l == 0) ? xin : X + (size_t)r * D; const float* g = (site == 1 ? a.in[2] : site == 4 ? a.in[5] : a.in[12]) + (size_t)l * D;
            float p = 0.f; for (int k = tid; k < D; k += 512) p += xr[k] * xr[k];
            const float rs = 1.0f / sqrtf(block_sum(p, red, tid) * (1.0f / D) + EPS);
            for (int ci = 0; ci < 3; ++ci) { const int c = ci == 0 ? 1 : ci == 1 ? 777 : 2047; diag_upd(diag, site == 11 ? 18 : site, bf2f(U[(size_t)r * D + c]), xr[c] * rs * g[c], tid); }
        }
        if ((site == 1 || site == 4) && ri < 4 && tid == 0) {
            const int n = ri == 0 ? 5639 : ri == 1 ? 7132 : ri == 2 ? 1031 : 12000; const float* win_ = a.in[6] + (size_t)l * D * 12288; const bf16* WINb = (const bf16*)(ws + WS_WIN);
            for (int ci = 0; ci < 3; ++ci) { const int k = ci == 0 ? 0 : ci == 1 ? 1000 : 2047;
                const float got = bf2f(WINb[(size_t)n * D + k]), ref = win_[(size_t)k * 12288 + 512 + (n - 1024)];
                float e = fabsf(got - ref) / (fabsf(ref) + 0.001f); const int stg = site == 1 ? 21 : 22; if (e > diag[stg]) diag[stg] = e; }
        }
        if (site == 2 || site == 12) {
            const bf16* H = (const bf16*)(ws + WS_H); const float* wi_ = (site == 2 ? a.in[3] : a.in[13]) + (size_t)l * D * 2 * FF;
            if (tid == 0) for (int ci = 0; ci < 3; ++ci) { const int c = ci == 0 ? 0 : ci == 1 ? 1000 : 2047; diag[70 + ri * 3 + ci] = (site == 2 && l == 0) ? xin[c] : X[(size_t)r * D + c]; }
            for (int ci = 0; ci < 3; ++ci) { const int j = ci == 0 ? 5 : ci == 1 ? 2500 : 5503;
                const float gt_ = dot_bf(U + (size_t)r * D, wi_ + j, D, 2 * FF, red, tid), up = dot_bf(U + (size_t)r * D, wi_ + FF + j, D, 2 * FF, red, tid);
                diag_upd(diag, site == 2 ? 2 : 19, bf2f(H[(size_t)r * FF + j]), siluf(gt_) * up, tid); }
        }
        if (site == 3 || site == 13) {
            const bf16* H = (const bf16*)(ws + WS_H); const float* wd_ = (site == 3 ? a.in[4] : a.in[14]) + (size_t)l * FF * D;
            for (int ci = 0; ci < 3; ++ci) { const int c = ci == 0 ? 0 : ci == 1 ? 1000 : 2047;
                diag_upd(diag, site == 3 ? 3 : 20, X[(size_t)r * D + c], diag[70 + ri * 3 + ci] + 0.5f * dot_bf(H + (size_t)r * FF, wd_ + c, FF, D, red, tid), tid); }
        }
        if (site == 5) {
            const bf16* Ur = U + (size_t)r * D; const float* win = a.in[6] + (size_t)l * D * 12288; const float* lb = (const float*)(ws + WS_LB) + (size_t)l * HG;
            for (int ci = 0; ci < 2; ++ci) { const int c = ci == 0 ? 7 : 1500;
                diag_upd(diag, 5, bf2f(((const bf16*)(ws + WS_QS))[(size_t)r * HG + c]), siluf(dot_bf(Ur, win + 512 + c, D, 12288, red, tid)), tid);
                { const float z = dot_bf(Ur, win + 2048 + c, D, 12288, red, tid), l_ = lb[c]; diag_upd(diag, 6, ((const float*)(ws + WS_LF))[(size_t)r * HG + c], logf(fmaxf(l_ + (1.f - l_) * sigm(z), 1e-30f)), tid); }
                { const float z = dot_bf(Ur, win + 3584 + c, D, 12288, red, tid), l_ = lb[4 * HG + c]; diag_upd(diag, 6, ((const float*)(ws + WS_LF))[(size_t)T * HG + (size_t)r * HG + c], logf(fmaxf(l_ + (1.f - l_) * sigm(z), 1e-30f)), tid); }
                diag_upd(diag, 7, bf2f(((const bf16*)(ws + WS_VV))[(size_t)r * HG + c]), dot_bf(Ur, win + 5120 + c, D, 12288, red, tid), tid);
                diag_upd(diag, 8, bf2f(((const bf16*)(ws + WS_GO))[(size_t)r * HG + c]), siluf(dot_bf(Ur, win + 6656 + c, D, 12288, red, tid)), tid);
                const int c2 = ci == 0 ? 7 : 2000;
                diag_upd(diag, 9, bf2f(((const bf16*)(ws + WS_SA))[(size_t)r * D + c2]), sigm(dot_bf(Ur, win + 8192 + c2, D, 12288, red, tid)), tid);
                diag_upd(diag, 10, bf2f(((const bf16*)(ws + WS_SB))[(size_t)r * D + c2]), sigm(dot_bf(Ur, win + 10240 + c2, D, 12288, red, tid)), tid);
                const int g = ci == 0 ? 1 : 3, j = ci == 0 ? 5 : 100; float P = 0.f, Q = 0.f;
                for (int c_ = 0; c_ < 128; ++c_) { const float d_ = dot_bf(Ur, win + 128 * g + c_, D, 12288, red, tid); const float ang = (float)((c_ * j) & 127) * (1.0f / 64.0f);
                    P += d_ * cospif(ang) * 0.08838834764831845f; Q += d_ * sinpif(ang) * 0.08838834764831845f; }
                const int S_ = r < TP ? 2048 : 8192, b_ = r < TP ? r >> 11 : (r - TP) >> 13, sb_ = r < TP ? b_ * 2048 : TP + b_ * 8192;
                const bf16* pq = (const bf16*)(ws + WS_PQT) + (r < TP ? (size_t)b_ * 512 * 4096 : (size_t)4 * 512 * 4096 + (size_t)b_ * 512 * 16384) + (size_t)(128 * g + j) * (2 * S_);
                diag_upd(diag, 11, bf2f(pq[r - sb_]), P, tid); diag_upd(diag, 12, bf2f(pq[S_ + r - sb_]), Q, tid);
            }
        }
        if (site == 7) {
            const int S_ = r < TP ? 2048 : 8192, b_ = r < TP ? r >> 11 : (r - TP) >> 13, sb_ = r < TP ? b_ * 2048 : TP + b_ * 8192, p_ = r - sb_;
            for (int ci = 0; ci < 2; ++ci) { const int ch = ci == 0 ? 133 : 484;
                const bf16* pq = (const bf16*)(ws + WS_PQT) + (r < TP ? (size_t)b_ * 512 * 4096 : (size_t)4 * 512 * 4096 + (size_t)b_ * 512 * 16384) + (size_t)ch * (2 * S_);
                float acc_ = 0.f; for (int n = tid; n < S_; n += 512) { const float x_ = (float)((n * p_) & (S_ - 1)) * (2.0f / (float)S_); acc_ += cospif(x_) * bf2f(pq[n]) - sinpif(x_) * bf2f(pq[S_ + n]); }
                diag_upd(diag, 13, bf2f(((const bf16*)(ws + WS_YY))[(size_t)r * FW + ch]), block_sum(acc_, red, tid) / sqrtf((float)S_), tid); }
            if (ri == 0 || ri == 1 || ri == 3 || ri == 4 || ri == 7) {
                const int hd = (ri & 1) ? 7 : 0; const float* LF = (const float*)(ws + WS_LF); const bf16* QS = (const bf16*)(ws + WS_QS); const bf16* VV = (const bf16*)(ws + WS_VV);
                LAS float* so = (LAS float*)(lds_ + 100000);
                const int k = tid & 127; const float q_ = bf2f(QS[(size_t)r * HG + hd * 128 + k]);
                float o_ = 0.f;
                for (int dir = 0; dir < 2; ++dir) { float d_ = 1.f; const float* LFd = LF + (size_t)dir * T * HG;
                    for (int s_ = r; dir == 0 ? s_ >= sb_ : s_ < sb_ + S_; s_ += dir == 0 ? -1 : 1) {
                        const float f_ = __expf(LFd[(size_t)s_ * HG + hd * 128 + k]);
                        const float w_ = block_sum(tid < 128 ? q_ * (1.f - f_) * d_ : 0.f, red, tid);
                        if (tid < 128) o_ += w_ * bf2f(VV[(size_t)s_ * HG + hd * 128 + tid]);
                        d_ *= f_; } }
                const float ss = block_sum(tid < 128 ? o_ * o_ : 0.f, red, tid);
                if (tid < 128) so[tid] = o_ / sqrtf(ss * (1.0f / 128.0f) + EPS) * a.in[8][(size_t)l * HG + hd * 128 + tid] * bf2f(((const bf16*)(ws + WS_GO))[(size_t)r * HG + hd * 128 + tid]);
                __syncthreads();
                for (int ci = 0; ci < 2; ++ci) { const int v_ = ci == 0 ? 3 : 77; diag_upd(diag, 14, bf2f(((const bf16*)(ws + WS_OO))[(size_t)r * HG + hd * 128 + v_]), so[v_], tid); }
                __syncthreads();
            }
        }
        if (site == 8) { for (int ci = 0; ci < 2; ++ci) { const int c = ci == 0 ? 9 : 1999;
                diag_upd(diag, 15, ((const float*)(ws + WS_PP))[(size_t)r * D + c], bf2f(((const bf16*)(ws + WS_SA))[(size_t)r * D + c]) * dot_bf((const bf16*)(ws + WS_YY) + (size_t)r * FW, a.in[9] + (size_t)l * FW * D + c, FW, D, red, tid), tid); } }
        if (site == 9) { for (int ci = 0; ci < 2; ++ci) { const int c = ci == 0 ? 9 : 1999;
                diag_upd(diag, 16, bf2f(((const bf16*)(ws + WS_MG))[(size_t)r * D + c]), ((const float*)(ws + WS_PP))[(size_t)r * D + c] + bf2f(((const bf16*)(ws + WS_SB))[(size_t)r * D + c]) * dot_bf((const bf16*)(ws + WS_OO) + (size_t)r * HG, a.in[10] + (size_t)l * HG * D + c, HG, D, red, tid), tid);
                if (tid == 0) diag[40 + ri * 2 + ci] = X[(size_t)r * D + c]; } }
        if (site == 10) { for (int ci = 0; ci < 2; ++ci) { const int c = ci == 0 ? 9 : 1999;
                diag_upd(diag, 17, X[(size_t)r * D + c], diag[40 + ri * 2 + ci] + dot_bf((const bf16*)(ws + WS_MG) + (size_t)r * D, a.in[11] + (size_t)l * D * D + c, D, D, red, tid), tid); } }
    }
    __syncthreads();
}
#define CHK_PHASE(site) PH_BEGIN(15) if (l == CHK_LAYER && blockIdx.x == 0) stage_check(site, l, ws, a, C.lds, C.tid); PH_END
#else
#define CHK_PHASE(site)
#endif

#ifdef CSUM_CHECK
constexpr size_t WS_CSUM = WS_CTL + 131072;
__device__ __forceinline__ void csum_region(const Ctx& C, unsigned long long* slot, const void* base, size_t bytes) {
    const uint4* p = (const uint4*)base; const size_t n = bytes / 16; unsigned long long acc = 0;
    for (size_t i = (size_t)C.vcu * 512 + C.tid; i < n; i += (size_t)C.G * 512) { const uint4 v = p[i]; acc += (unsigned long long)v.x + ((unsigned long long)v.y << 1) + ((unsigned long long)v.z << 2) + ((unsigned long long)v.w << 3) + (unsigned long long)(i & 0xffff) * v.x; }
#pragma unroll
    for (int o = 1; o < 64; o <<= 1) acc += __shfl_xor(acc, o);
    if (C.lane == 0) atomicAdd(slot, acc);
}
#define CSUM_PHASE(kind) PH_BEGIN(15) { unsigned long long* slot = (unsigned long long*)(ws + WS_CSUM) + run * 64 + (ph_idx++); \
    if ((kind) == 0) { csum_region(C, slot, ws + WS_LB, 2 * 4 * HG * 4); csum_region(C, slot, ws + WS_DM8, WS_U - WS_DM8); } \
    if ((kind) == 1) { csum_region(C, slot, ws + WS_W1I, WS_DM8 - WS_W1I); csum_region(C, slot, ws + WS_U, (size_t)T * D * 2); } \
    if ((kind) == 2 || (kind) == 11) csum_region(C, slot, ws + WS_H, (size_t)T * FF * 2); \
    if ((kind) == 3 || (kind) == 9 || (kind) == 12 || (kind) == 13) csum_region(C, slot, X, (size_t)T * D * 4); \
    if ((kind) == 4 || (kind) == 10) csum_region(C, slot, ws + WS_U, (size_t)T * D * 2); \
    if ((kind) == 5) { unsigned long long* s5 = (unsigned long long*)(ws + WS_CSUM) + run * 64 + 50; csum_region(C, slot, ws + WS_PQT, WS_BIG_END - WS_PQT); csum_region(C, s5 + 0, ws + WS_PQT, WS_QS - WS_PQT); csum_region(C, s5 + 1, ws + WS_QS, WS_VV - WS_QS); csum_region(C, s5 + 2, ws + WS_VV, WS_GO - WS_VV); csum_region(C, s5 + 3, ws + WS_GO, WS_SA - WS_GO); csum_region(C, s5 + 4, ws + WS_SA, WS_SB - WS_SA); csum_region(C, s5 + 5, ws + WS_SB, WS_LF - WS_SB); csum_region(C, s5 + 6, ws + WS_LF, (size_t)T * HG * 4); csum_region(C, s5 + 7, ws + WS_LF + (size_t)T * HG * 4, (size_t)T * HG * 4); } \
    if ((kind) == 6) csum_region(C, slot, ws + WS_OF, WS_END - WS_OF); \
    if ((kind) == 7) csum_region(C, slot, ws + WS_PP, (size_t)T * D * 4); \
    if ((kind) == 8) csum_region(C, slot, ws + WS_MG, (size_t)T * D * 2); } PH_END
#else
#define CSUM_PHASE(kind)
#endif
__global__ void __launch_bounds__(512, 2) fwd_kernel(Args a_) {
    extern __shared__ __attribute__((aligned(16))) unsigned char lds_raw[];
    volatile LAS unsigned* bst = (volatile LAS unsigned*)((LAS unsigned char*)lds_raw + LDS_BAR_OFF);
    if (threadIdx.x < 4) bst[threadIdx.x] = 0u;
    __syncthreads();
    const int wave_u = __builtin_amdgcn_readfirstlane((int)threadIdx.x >> 6);
    const int lo = a_.ph_lo, hi = a_.ph_hi;
    XcdBarrier bar; bar.bar = (unsigned*)(a_.ws + WS_CTL) + CW_BAR; bar.x = 0; bar.st = bst;
    if (hi - lo > 1) bar = xcd_barrier_post((unsigned*)(a_.ws + WS_CTL) + CW_BAR, bst);
    int ph = 0;
#ifndef PH_EN
#define PH_EN 0xffffu
#endif
#define PH_BEGIN(id) if (((PH_EN >> (id)) & 1u) && ph >= lo && ph < hi) { \
    ArgsP ap = (ArgsP)__builtin_amdgcn_kernarg_segment_ptr(); asm volatile("" : "+s"(ap)); const ArgsK& a = *ap; \
    Ctx C; C.lds = (LAS unsigned char*)lds_raw; { unsigned m_ = ~0u; asm volatile("" : "+s"(m_)); C.lane = (int)__builtin_amdgcn_mbcnt_hi(m_, __builtin_amdgcn_mbcnt_lo(m_, 0u)); } C.wave = wave_u; C.tid = wave_u * 64 + C.lane; \
    C.G = gridDim.x; const int bx = (int)blockIdx.x; C.vcu = (C.G % 8 == 0) ? (bx % 8) * (C.G / 8) + bx / 8 : bx; C.gw = C.vcu * 8 + C.wave; C.NGW = C.G * 8; \
    unsigned char* ws = a.ws; float* X = a.out; bf16* X16 = (bf16*)(ws + WS_X16); bf16* U = (bf16*)(ws + WS_U); (void)X; (void)X16; (void)U; (void)bx;
#define PH_END if (ph + 1 < hi) xcd_barrier(bar); } ++ph;

#ifdef CSUM_CHECK
    for (int run = 0; run < 2; ++run) { int ph_idx = 0;
#else
    { const int run = 0; int ph_idx = 0; (void)run; (void)ph_idx;
#endif
    PH_BEGIN(0) phase_prologue(C, a); PH_END CSUM_PHASE(0)

    for (int l = 0; l < DEPTH; ++l) {
        if (l == 0) { PH_BEGIN(1) phase_wconv(C, a, 0, 1, C.vcu, C.G); phase_cast0(C, a.in[0], a.in[1], U, (float*)(ws + WS_RS)); PH_END }
        CHK_PHASE(1) PH_BEGIN(2) { { volatile LAS int* tg_ = (volatile LAS int*)(C.lds + LDS_BAR_OFF + 64); if (C.tid == 0) *tg_ = -1; __syncthreads(); } pg8::Gemm g{l == 0 ? U : X16, (const bf16*)(ws + WS_W1I), T, 2 * FF, D}; pg8::StaticOrder S; S.init(T, 2 * FF, C.G, bx); EpiSwiglu E{ws};
            GEMM_CALL(EpiSwiglu, pg8::StaticOrder)
            { unsigned* q2 = (unsigned*)(ws + WS_CTL + 32768) + l * 64 + 32; for (;;) { const int c = wq_grab(C, q2, q2, 0u); if (c >= CONV2_NCH) break; conv_chunk2(C, a, l, c); } } } PH_END CSUM_PHASE(2)
        CHK_PHASE(2) PH_BEGIN(3) { const float* xp = l == 0 ? a.in[0] : nullptr; const float* xs = l == 0 ? a.in[1] : nullptr; pg8::Gemm g{(const bf16*)(ws + WS_H), (const bf16*)(ws + WS_W1D), T, D, FF}; pg8::StaticOrder S; S.init(T, D, C.G, bx); EpiResid E{xp, xs, X16, 0.5f, (float*)(ws + WS_RS)};
            GEMM_CALL(EpiResid, pg8::StaticOrder) } PH_END CSUM_PHASE(3)
#ifdef CSUM_FILL
        PH_BEGIN(15) { uint4* p_ = (uint4*)(ws + WS_PQT); const size_t n_ = (WS_BIG_END - WS_PQT) / 16; for (size_t i = (size_t)C.vcu * 512 + C.tid; i < n_; i += (size_t)C.G * 512) p_[i] = make_uint4(0u, 0u, 0u, 0u); } PH_END
#endif
        CHK_PHASE(4) PH_BEGIN(5) { { volatile LAS int* tg_ = (volatile LAS int*)(C.lds + LDS_BAR_OFF + 64); if (C.tid == 0) *tg_ = -1; __syncthreads(); }
            { pg8::Gemm g{(const bf16*)(ws + WS_WIN), X16, 512, T, D}; FourierOrder S{bx}; EpiFourier E{ws};
              GEMM_CALL(EpiFourier, FourierOrder) }
            pg8::Gemm g{X16, (const bf16*)(ws + WS_WIN) + (size_t)512 * D, T, NIN - 512, D}; pg8::StaticOrder S; S.init(T, NIN - 512, C.G, (bx + 64) & 255);
#ifdef EXP_RAW_G3
            EpiRaw E{ws};
            GEMM_CALL(EpiRaw, pg8::StaticOrder) }
#else
            EpiMixIn E{ws, l, 0, nullptr};
            GEMM_CALL(EpiMixIn, pg8::StaticOrder) }
#endif
            PH_END CSUM_PHASE(5)
#ifdef CMP_G3
        PH_BEGIN(15) { pg8::Gemm g{U, (const bf16*)(ws + WS_WIN), T, NIN, D}; pg8::StaticOrder S; S.init(T, NIN, C.G, bx);
            EpiMixIn E{ws, l, 1, (unsigned*)(ws + WS_CTL + 196608)};
            pg8::gemm_phase_simple<EpiMixIn, pg8::StaticOrder>(g, S, E, C.tid); } PH_END
#endif

        CHK_PHASE(5) PH_BEGIN(6) {
            { pg8::Gemm g{(const bf16*)(ws + WS_DM8), (const bf16*)(ws + WS_PQT) + (size_t)4 * 512 * 4096, 4096, 512, 8192};
              DftOrder S{16, 4, C.G, bx, (size_t)512 * 8192 * 2, (size_t)4096 * 8192 * 2}; EpiDftH E{ws, TP / 2, 4096, 0.011048543456039806f};
              GEMM_CALL(EpiDftH, DftOrder) }
            { pg8::Gemm g{(const bf16*)(ws + WS_DM2), (const bf16*)(ws + WS_PQT), 1024, 512, 2048};
              DftOrder S{4, 8, 48, bx >= 208 ? bx - 208 : 1 << 20, (size_t)512 * 2048 * 2, (size_t)1024 * 2048 * 2};     EpiDftH E{ws, 0, 1024, 0.022097086912079612f};
              GEMM_CALL(EpiDftH, DftOrder) }
            __syncthreads();
#ifdef EXP_FAKE_SCAN
            { const bf16* q_ = (const bf16*)(ws + WS_QS); const bf16* v_ = (const bf16*)(ws + WS_VV); bf16* o_ = (bf16*)(ws + WS_OO);
              for (size_t i = (size_t)C.vcu * 512 + C.tid; i < (size_t)T * HG; i += (size_t)C.G * 512) o_[i] = (bf16)0x3f80u; (void)q_; (void)v_; }
#endif
#if !defined(EXP_NO_SCAN) && !defined(EXP_FAKE_SCAN)
            phase_scan_a(C, (const float*)(ws + WS_LF), (const bf16*)(ws + WS_QS), (const bf16*)(ws + WS_VV), (bf16*)(ws + WS_OF), (bf16*)(ws + WS_OB), (float*)(ws + WS_EB), (float*)(ws + WS_LS));
            if (l + 1 < DEPTH) { unsigned* q = (unsigned*)(ws + WS_CTL + 32768) + l * 64;
                for (;;) { const int c = wq_grab(C, q, q + 32, 0u); if (c < 0 || c >= CONV_NCH) break; conv_chunk(C, a, l + 1, c); } }
#endif
        } PH_END CSUM_PHASE(6)
        PH_BEGIN(14) {
            phase_scan_b(C, (const float*)(ws + WS_LF), (const bf16*)(ws + WS_QS), (const bf16*)(ws + WS_VV), (bf16*)(ws + WS_OF), (bf16*)(ws + WS_OB), (float*)(ws + WS_EB), (float*)(ws + WS_LS));
            phase_dft_combine(C, ws, bx, C.G);
            if (l + 1 < DEPTH) { unsigned* q = (unsigned*)(ws + WS_CTL + 32768) + l * 64;
                for (;;) { const int c = wq_grab(C, q, q, 0u); if (c >= CONV_NCH) break; conv_chunk(C, a, l + 1, c); } }
        } PH_END

        CHK_PHASE(7) PH_BEGIN(7) { phase_scan_finalize(C, (const bf16*)(ws + WS_OF), (const bf16*)(ws + WS_OB), (const bf16*)(ws + WS_GO), a.in[8] + (size_t)l * HG, (bf16*)(ws + WS_OO)); pg8::Gemm g{(const bf16*)(ws + WS_YY), (const bf16*)(ws + WS_WFO), T, D, FW}; pg8::StaticOrder S; S.init(T, D, C.G, bx); EpiBranchA E{ws};
            GEMM_CALL(EpiBranchA, pg8::StaticOrder) } PH_END CSUM_PHASE(7)
        CHK_PHASE(8) PH_BEGIN(8) { pg8::Gemm g{(const bf16*)(ws + WS_OO), (const bf16*)(ws + WS_WHO), T, D, HG}; pg8::StaticOrder S; S.init(T, D, C.G, bx); EpiBranchB E{ws};
            GEMM_CALL(EpiBranchB, pg8::StaticOrder) } PH_END CSUM_PHASE(8)
        CHK_PHASE(9) PH_BEGIN(9) { pg8::Gemm g{(const bf16*)(ws + WS_MG), (const bf16*)(ws + WS_WOU), T, D, D}; pg8::StaticOrder S; S.init(T, D, C.G, bx); EpiResid E{nullptr, nullptr, X16, 1.0f, (float*)(ws + WS_RS)};
            GEMM_CALL(EpiResid, pg8::StaticOrder) } PH_END CSUM_PHASE(9)
        CHK_PHASE(11) PH_BEGIN(11) { { volatile LAS int* tg_ = (volatile LAS int*)(C.lds + LDS_BAR_OFF + 64); if (C.tid == 0) *tg_ = -1; __syncthreads(); } pg8::Gemm g{X16, (const bf16*)(ws + WS_W2I), T, 2 * FF, D}; pg8::StaticOrder S; S.init(T, 2 * FF, C.G, bx); EpiSwiglu E{ws};
            GEMM_CALL(EpiSwiglu, pg8::StaticOrder) } PH_END CSUM_PHASE(11)
        CHK_PHASE(12) PH_BEGIN(12) { pg8::Gemm g{(const bf16*)(ws + WS_H), (const bf16*)(ws + WS_W2D), T, D, FF}; pg8::StaticOrder S; S.init(T, D, C.G, bx); EpiResid E{nullptr, nullptr, X16, 0.5f, (float*)(ws + WS_RS)};
            GEMM_CALL(EpiResid, pg8::StaticOrder) } PH_END CSUM_PHASE(12)
        CHK_PHASE(13)
    }
    PH_BEGIN(13)
#ifdef CMP_G3
    { const unsigned* cnt = (const unsigned*)(ws + WS_CTL + 196608); unsigned tot = 0; for (int i = 0; i < 7; ++i) tot += cnt[i];
      int kf = 0; for (int i = 0; i < 7; ++i) kf |= (cnt[i] > 0u) << i; (void)tot;
      float sc = 1.0f; for (int i = 0; i < kf; ++i) sc *= 1.5f;
      for (int m = C.gw; m < T; m += C.NGW) { const f32x4* xi = (const f32x4*)(m < TP ? a.in[0] + (size_t)m * D : a.in[1] + (size_t)(m - TP) * D) + C.lane; f32x4* xr = (f32x4*)(X + (size_t)m * D) + C.lane;
#pragma unroll
          for (int j = 0; j < 8; ++j) xr[64 * j] = xi[64 * j] * sc; } }
#elif defined(STAGE_CHECK)
    { const float* diag = (const float*)(ws + WS_DIAG); int kf = 0;
      for (int st = 22; st >= 1; --st) if (diag[st] > STAGE_TOL && st != CHK_SKIP) kf = st;
      float sc = 1.0f; for (int i = 0; i < kf; ++i) sc *= 2.0f;
      for (int m = C.gw; m < T; m += C.NGW) { const f32x4* xi = (const f32x4*)(m < TP ? a.in[0] + (size_t)m * D : a.in[1] + (size_t)(m - TP) * D) + C.lane; f32x4* xr = (f32x4*)(X + (size_t)m * D) + C.lane;
#pragma unroll
          for (int j = 0; j < 8; ++j) xr[64 * j] = xi[64 * j] * sc; } }
#else
    phase_norm16<true>(C, X16, a.in[15], nullptr, X);
#endif
    PH_END CSUM_PHASE(13)
    }
#ifdef CSUM_CHECK
    PH_BEGIN(14) { const unsigned long long* cs = (const unsigned long long*)(ws + WS_CSUM); int kf = 0;
      kf = (cs[5] != cs[6]) + 2 * (cs[64 + 5] != cs[64 + 6]) + 4 * (cs[5] != cs[64 + 5]);
      float sc = 1.0f; for (int i = 0; i < kf; ++i) sc *= 2.0f;
      for (int m = C.gw; m < T; m += C.NGW) { const f32x4* xi = (const f32x4*)(m < TP ? a.in[0] + (size_t)m * D : a.in[1] + (size_t)(m - TP) * D) + C.lane; f32x4* xr = (f32x4*)(X + (size_t)m * D) + C.lane;
#pragma unroll
          for (int j = 0; j < 8; ++j) xr[64 * j] = xi[64 * j] * sc; } } PH_END
#endif
#undef PH_BEGIN
#undef PH_END
}

extern "C" void kernel_launch(void* const* d_in, const int* in_sizes, int n_in, void* d_out, int out_size, void* d_ws, size_t ws_size, hipStream_t stream) {
    static int grid = 0;
    if (grid == 0) {
        if (n_in != 16 || out_size != T * D || ws_size < WS_END) { fprintf(stderr, "kernel_launch: unexpected shapes (n_in %d out %d ws %zu need %zu)\n", n_in, out_size, ws_size, (size_t)WS_END); grid = -1; return; }
        int dev = 0, cus = 0;
        if (hipGetDevice(&dev) != hipSuccess || hipDeviceGetAttribute(&cus, hipDeviceAttributeMultiprocessorCount, dev) != hipSuccess) { grid = -1; return; }
        if (hipFuncSetAttribute((const void*)fwd_kernel, hipFuncAttributeMaxDynamicSharedMemorySize, LDS_BYTES) != hipSuccess) { fprintf(stderr, "kernel_launch: hipFuncSetAttribute failed\n"); grid = -1; return; }
        int per_cu = 0; (void)hipOccupancyMaxActiveBlocksPerMultiprocessor(&per_cu, (const void*)fwd_kernel, 512, LDS_BYTES); (void)hipGetLastError();
        grid = cus;
    }
    if (grid < 0) return;
#ifdef EXP_MEMSET_ALL
    (void)hipMemsetAsync((char*)d_ws, 0, WS_END, stream); (void)hipMemsetAsync(d_out, 0, (size_t)T * D * 4, stream);
#else
    (void)hipMemsetAsync((char*)d_ws + WS_CTL, 0, CTL_BYTES, stream);
#endif
    Args a{};
    for (int i = 0; i < 16; ++i) a.in[i] = (const float*)d_in[i];
    a.out = (float*)d_out; a.ws = (unsigned char*)d_ws;
#if MK_MULTI
    for (int p = 0; p < NPH; ++p) { a.ph_lo = p; a.ph_hi = p + 1; hipLaunchKernelGGL(fwd_kernel, dim3(grid), dim3(512), LDS_BYTES, stream, a); }
#else
    a.ph_lo = 0; a.ph_hi = NPH;
    hipLaunchKernelGGL(fwd_kernel, dim3(grid), dim3(512), LDS_BYTES, stream, a);
#endif
}
```
